# Optimizing an MI355X kernel written in HIP

```python
import math
import jax, jax.numpy as jnp
from jax import lax
import numpy as np

D_MODEL = 2048
BATCH = 4
SEQ = 2048
DEPTH = 4

GRID_W = 64
CTX_LEN = 256

D_MIX = D_MODEL
MLA_V = 128
MLA_NOPE = 128
MLA_ROPE = 64
MLA_W = D_MIX // 2
MLA_HEADS = MLA_W // MLA_V
MLA_Q_RANK = 512
MLA_KV_RANK = 256
MLA_SCALE = (MLA_NOPE + MLA_ROPE) ** -0.5
MLA_QB = 128
LRU_W = D_MIX // 4
LRU_BLOCKS = 8
LRU_BW = LRU_W // LRU_BLOCKS
LRU_CONV = 4
LRU_C = 8.0
RET_HEADS = 4
RET_DH = 128
RET_W = RET_HEADS * RET_DH
RET_CHUNK = 128
RET_K_SCALE = RET_DH ** -0.5

ROPE_BASE = 10000.0
LN_EPS = 1e-5
RMS_EPS = 1e-6
ALPHA = (2 * DEPTH) ** 0.25
BETA = (8 * DEPTH) ** -0.25

SPLITS = (MLA_Q_RANK, MLA_KV_RANK, MLA_ROPE, MLA_W,
          LRU_W, LRU_W,
          RET_W, RET_W, RET_W, RET_W)
MIX_IN = sum(SPLITS)

kernel_name = 'hybrid_mla_rglru_retention_dit'


def layer_norm(x, g=None, b=None):
    xf = x.astype(jnp.float32)
    mu = jnp.mean(xf, axis=-1, keepdims=True)
    var = jnp.mean(jnp.square(xf - mu), axis=-1, keepdims=True)
    y = (xf - mu) * lax.rsqrt(var + LN_EPS)
    if g is not None:
        y = y * g.astype(jnp.float32) + b.astype(jnp.float32)
    return y.astype(x.dtype)


def rms_norm(x, g):
    xf = x.astype(jnp.float32)
    y = xf * lax.rsqrt(jnp.mean(jnp.square(xf), axis=-1, keepdims=True) + RMS_EPS)
    return (y * g.astype(jnp.float32)).astype(x.dtype)


def split_cols(u):
    offsets = np.cumsum(SPLITS)[:-1].tolist()
    return jnp.split(u, offsets, axis=-1)


def ada_mod(cond, w, b):
    m = jax.nn.silu(cond) @ w + b
    return jnp.split(m, 3, axis=-1)


def axial_rope_tables(rows, dim, dtype):
    row = jnp.repeat(jnp.arange(rows, dtype=jnp.float32), GRID_W)
    col = jnp.tile(jnp.arange(GRID_W, dtype=jnp.float32), rows)
    quarter = dim // 4
    inv = ROPE_BASE ** (-jnp.arange(quarter, dtype=jnp.float32) / quarter)
    ang = jnp.stack([row[:, None] * inv, col[:, None] * inv], axis=1)
    return jnp.cos(ang).astype(dtype), jnp.sin(ang).astype(dtype)


def apply_rope(x, cos, sin):
    shp = x.shape
    xr = x.reshape(shp[:-1] + (2, 2, shp[-1] // 4))
    if x.ndim == 4:
        cos, sin = cos[:, None], sin[:, None]
    x1, x2 = xr[..., 0, :], xr[..., 1, :]
    out = jnp.stack([x1 * cos - x2 * sin, x2 * cos + x1 * sin], axis=-2)
    return out.reshape(shp)


def mla_queries(q_lat, g, w_uq):
    B, T, _ = q_lat.shape
    q = (rms_norm(q_lat, g) @ w_uq).reshape(B, T, MLA_HEADS, MLA_NOPE + MLA_ROPE)
    return q[..., :MLA_NOPE], q[..., MLA_NOPE:]


def mla_kv(kv_lat, g, w_ukv):
    B, T, _ = kv_lat.shape
    kv = (rms_norm(kv_lat, g) @ w_ukv).reshape(B, T, MLA_HEADS, MLA_NOPE + MLA_V)
    return kv[..., :MLA_NOPE], kv[..., MLA_NOPE:]


def mla_scores(qn, qr, kn, kr):
    return jnp.einsum('bqhd,bkhd->bhqk', qn, kn) + jnp.einsum('bqhd,bkd->bhqk', qr, kr)


def softmax_attend(s, v):
    p = jax.nn.softmax(s.astype(jnp.float32) * MLA_SCALE, axis=-1).astype(v.dtype)
    return jnp.einsum('bhqk,bkhd->bqhd', p, v)


def mla_latent(qn, qr, kn_all, kr_all, v_all):
    B, T = qn.shape[:2]
    nb = T // MLA_QB

    def to_blocks(a):
        return a.reshape((B, nb, MLA_QB) + a.shape[2:]).swapaxes(0, 1)

    def block(args):
        bqn, bqr = args
        return softmax_attend(mla_scores(bqn, bqr, kn_all, kr_all), v_all)

    o = lax.map(block, (to_blocks(qn), to_blocks(qr)))
    return o.swapaxes(0, 1).reshape(B, T, MLA_W)


def mla_mixer(q_lat, kv_lat, k_rope, gate, q_lat_c, kv_lat_c, k_rope_c, gate_c,
              q_norm_g, kv_norm_g, w_uq, w_ukv, cos, sin, need_ctx_out):
    kn_c, v_c = mla_kv(kv_lat_c, kv_norm_g, w_ukv)
    kn, v = mla_kv(kv_lat, kv_norm_g, w_ukv)
    kr = apply_rope(k_rope, cos, sin)
    qn, qr = mla_queries(q_lat, q_norm_g, w_uq)
    qr = apply_rope(qr, cos, sin)
    kn_all = jnp.concatenate([kn_c, kn], axis=1)
    kr_all = jnp.concatenate([k_rope_c, kr], axis=1)
    v_all = jnp.concatenate([v_c, v], axis=1)
    y = mla_latent(qn, qr, kn_all, kr_all, v_all) * jax.nn.silu(gate)
    yc = None
    if need_ctx_out:
        B, L = q_lat_c.shape[:2]
        qn_c, qr_c = mla_queries(q_lat_c, q_norm_g, w_uq)
        o_c = softmax_attend(mla_scores(qn_c, qr_c, kn_c, k_rope_c), v_c)
        yc = o_c.reshape(B, L, MLA_W) * jax.nn.silu(gate_c)
    return y, yc


def short_conv(x, w, b):
    T = x.shape[1]
    left = LRU_CONV // 2
    xp = jnp.pad(x, ((0, 0), (left, LRU_CONV - 1 - left), (0, 0)))
    return sum(xp[:, k:k + T] * w[k] for k in range(LRU_CONV)) + b


def block_diag(x, w, b):
    B, T, _ = x.shape
    y = jnp.einsum('btgi,gij->btgj', x.reshape(B, T, LRU_BLOCKS, LRU_BW), w)
    return y.reshape(B, T, LRU_W) + b


def rglru_coeffs(x, w_r, b_r, w_i, b_i, lam):
    r = jax.nn.sigmoid(block_diag(x, w_r, b_r))
    i = jax.nn.sigmoid(block_diag(x, w_i, b_i))
    log_a = -LRU_C * r * jax.nn.softplus(-lam)
    a = jnp.exp(log_a)
    return a, jnp.sqrt(-jnp.expm1(2.0 * log_a)) * (i * x)


def _lin_combine(e1, e2):
    a1, b1 = e1
    a2, b2 = e2
    return a1 * a2, a2 * b1 + b2


def linear_scan(a, b, h0, reverse):
    if reverse:
        b = b.at[:, -1].add(a[:, -1] * h0)
    else:
        b = b.at[:, 0].add(a[:, 0] * h0)
    _, h = lax.associative_scan(_lin_combine, (a, b), axis=1, reverse=reverse)
    return h


def rglru_mixer(x_lat, gate, x_ctx, gate_c, conv_w, conv_b, w_r, b_r, w_i, b_i, lam, need_ctx_out):
    xl = short_conv(x_lat, conv_w, conv_b)
    xc = short_conv(x_ctx, conv_w, conv_b)
    outs, outs_c = [], []
    for d, reverse in ((0, False), (1, True)):
        a_c, b_c = rglru_coeffs(xc, w_r[d], b_r[d], w_i[d], b_i[d], lam[d])
        h_c = linear_scan(a_c, b_c, jnp.zeros_like(xc[:, 0]), reverse)
        h_c_last = h_c[:, 0] if reverse else h_c[:, -1]
        a, b = rglru_coeffs(xl, w_r[d], b_r[d], w_i[d], b_i[d], lam[d])
        outs.append(linear_scan(a, b, h_c_last, reverse))
        outs_c.append(h_c)
    y = (outs[0] + outs[1]) * jax.nn.silu(gate)
    yc = (outs_c[0] + outs_c[1]) * jax.nn.silu(gate_c) if need_ctx_out else None
    return y, yc


def retention_dir(q, k, v, log_g, r0, include_diag):
    B, T, H, dk = q.shape
    nc = T // RET_CHUNK
    qc = q.reshape(B, nc, RET_CHUNK, H, dk)
    kc = k.reshape(B, nc, RET_CHUNK, H, dk)
    vc = v.reshape(B, nc, RET_CHUNK, H, v.shape[-1])
    idx = jnp.arange(RET_CHUNK, dtype=jnp.float32)
    diff = idx[:, None] - idx[None, :]
    mask = diff >= 0 if include_diag else diff > 0
    decay = jnp.where(mask[None], jnp.exp(jnp.where(mask, diff, 0.0)[None] * log_g[:, None, None]), 0.0)
    decay = decay.astype(q.dtype)
    s = jnp.einsum('bcqhd,bckhd->bchqk', qc, kc) * decay
    inner = jnp.einsum('bchqk,bckhe->bcqhe', s, vc)
    zeta = jnp.exp((RET_CHUNK - 1 - idx)[:, None] * log_g[None]).astype(q.dtype)
    xi = jnp.exp((idx + 1)[:, None] * log_g[None]).astype(q.dtype)
    g_chunk = jnp.exp(RET_CHUNK * log_g).astype(q.dtype)[:, None, None]
    kv_chunk = jnp.einsum('bckhd,kh,bckhe->bchde', kc, zeta, vc)

    def step(r, kv):
        return g_chunk * r + kv, r

    _, r_prev = lax.scan(step, r0, kv_chunk.swapaxes(0, 1))
    cross = jnp.einsum('bcqhd,qh,cbhde->bcqhe', qc, xi, r_prev)
    return (inner + cross).reshape(B, T, H, v.shape[-1])


def retention_ctx_state(k, v, log_g, reverse):
    L = k.shape[1]
    pos = jnp.arange(L, dtype=jnp.float32)
    expo = pos if reverse else (L - 1 - pos)
    w = jnp.exp(expo[:, None] * log_g[None]).astype(k.dtype)
    return jnp.einsum('blhd,lh,blhe->bhde', k, w, v)


def bidir_retention(q, k, v, log_g, r_f, r_b):
    flip = lambda a: jnp.flip(a, axis=1)
    fwd = retention_dir(q, k, v, log_g[0], r_f, True)
    bwd = flip(retention_dir(flip(q), flip(k), flip(v), log_g[1], r_b, False))
    return fwd + bwd


def head_norm(o):
    B, T = o.shape[:2]
    return layer_norm(o).reshape(B, T, RET_W)


def retention_mixer(q, k, v, gate, q_c, k_c, v_c, gate_c, decay_raw, cos, sin, need_ctx_out):
    log_g = jax.nn.log_sigmoid(decay_raw.astype(jnp.float32))
    heads = lambda a: a.reshape(a.shape[0], a.shape[1], RET_HEADS, RET_DH)
    q = apply_rope(heads(q), cos, sin)
    k = apply_rope(heads(k), cos, sin) * RET_K_SCALE
    v = heads(v)
    kc = heads(k_c) * RET_K_SCALE
    vc = heads(v_c)
    r_f = retention_ctx_state(kc, vc, log_g[0], False)
    r_b = retention_ctx_state(kc, vc, log_g[1], True)
    y = head_norm(bidir_retention(q, k, v, log_g, r_f, r_b)) * jax.nn.silu(gate)
    yc = None
    if need_ctx_out:
        zeros = jnp.zeros_like(r_f)
        yc = head_norm(bidir_retention(heads(q_c), kc, vc, log_g, zeros, zeros)) * jax.nn.silu(gate_c)
    return y, yc


def setup_inputs(seed: int = 0) -> dict:
    key = jax.random.key(seed)
    ks = jax.random.split(key, 22)
    f32 = jnp.float32
    nrm = lambda k, shape, s: jax.random.normal(k, shape, f32) * s
    L = DEPTH
    u = jax.random.uniform(ks[17], (L, 2, LRU_W), f32, 0.9, 0.999)
    a0 = u ** (1.0 / LRU_C)
    lru_lambda = jnp.log(a0) - jnp.log1p(-a0)
    gamma0 = 1.0 - 2.0 ** (-5.0 - jnp.arange(RET_HEADS, dtype=f32))
    ret_decay = jnp.log(gamma0) - jnp.log1p(-gamma0) + nrm(ks[18], (L, 2, RET_HEADS), 0.05)
    return {
        'x': nrm(ks[0], (BATCH, SEQ, D_MODEL), 1.0),
        'c': nrm(ks[1], (BATCH, D_MODEL), 1.0),
        'ctx': nrm(ks[2], (BATCH, CTX_LEN, D_MODEL), 1.0),
        'c_ctx': nrm(ks[3], (D_MODEL,), 1.0),
        'w_ada': nrm(ks[4], (L, D_MODEL, 3 * D_MODEL), 0.5 * D_MODEL ** -0.5),
        'b_ada': nrm(ks[5], (L, 3 * D_MODEL), 0.02),
        'w_in': nrm(ks[6], (L, D_MODEL, MIX_IN), D_MODEL ** -0.5),
        'mla_q_norm_g': 1.0 + nrm(ks[7], (L, MLA_Q_RANK), 0.02),
        'mla_kv_norm_g': 1.0 + nrm(ks[8], (L, MLA_KV_RANK), 0.02),
        'mla_w_uq': nrm(ks[9], (L, MLA_Q_RANK, MLA_HEADS * (MLA_NOPE + MLA_ROPE)), MLA_Q_RANK ** -0.5),
        'mla_w_ukv': nrm(ks[10], (L, MLA_KV_RANK, MLA_HEADS * (MLA_NOPE + MLA_V)), MLA_KV_RANK ** -0.5),
        'lru_conv_w': nrm(ks[11], (L, LRU_CONV, LRU_W), LRU_CONV ** -0.5),
        'lru_conv_b': nrm(ks[12], (L, LRU_W), 0.02),
        'lru_w_r': nrm(ks[13], (L, 2, LRU_BLOCKS, LRU_BW, LRU_BW), LRU_BW ** -0.5),
        'lru_b_r': nrm(ks[14], (L, 2, LRU_W), 0.02),
        'lru_w_i': nrm(ks[15], (L, 2, LRU_BLOCKS, LRU_BW, LRU_BW), LRU_BW ** -0.5),
        'lru_b_i': nrm(ks[16], (L, 2, LRU_W), 0.02),
        'lru_lambda': lru_lambda,
        'ret_decay': ret_decay,
        'w_out': nrm(ks[19], (L, D_MIX, D_MODEL), BETA * D_MIX ** -0.5),
        'ln_g': 1.0 + nrm(ks[20], (L, D_MODEL), 0.02),
        'ln_b': nrm(ks[21], (L, D_MODEL), 0.02),
    }


def reference(x, c, ctx, c_ctx, w_ada, b_ada, w_in, mla_q_norm_g, mla_kv_norm_g, mla_w_uq, mla_w_ukv,
              lru_conv_w, lru_conv_b, lru_w_r, lru_b_r, lru_w_i, lru_b_i, lru_lambda, ret_decay,
              w_out, ln_g, ln_b):
    rows = x.shape[1] // GRID_W
    cos_m, sin_m = axial_rope_tables(rows, MLA_ROPE, x.dtype)
    cos_r, sin_r = axial_rope_tables(rows, RET_DH, x.dtype)
    h = layer_norm(x)
    hc = layer_norm(ctx)
    for l in range(DEPTH):
        need_ctx_out = l < DEPTH - 1
        sh, sc, gt = ada_mod(c, w_ada[l], b_ada[l])
        shc, scc, gtc = ada_mod(c_ctx, w_ada[l], b_ada[l])
        u = split_cols((h * (1.0 + sc[:, None]) + sh[:, None]) @ w_in[l])
        uc = split_cols((hc * (1.0 + scc) + shc) @ w_in[l])
        y_mla, yc_mla = mla_mixer(u[0], u[1], u[2], u[3], uc[0], uc[1], uc[2], uc[3],
                                  mla_q_norm_g[l], mla_kv_norm_g[l], mla_w_uq[l], mla_w_ukv[l],
                                  cos_m, sin_m, need_ctx_out)
        y_lru, yc_lru = rglru_mixer(u[4], u[5], uc[4], uc[5], lru_conv_w[l], lru_conv_b[l],
                                    lru_w_r[l], lru_b_r[l], lru_w_i[l], lru_b_i[l], lru_lambda[l],
                                    need_ctx_out)
        y_ret, yc_ret = retention_mixer(u[6], u[7], u[8], u[9], uc[6], uc[7], uc[8], uc[9],
                                        ret_decay[l], cos_r, sin_r, need_ctx_out)
        y = jnp.concatenate([y_mla, y_lru, y_ret], axis=-1) @ w_out[l]
        h_new = layer_norm(ALPHA * h + gt[:, None] * y, ln_g[l], ln_b[l])
        if need_ctx_out:
            yc = jnp.concatenate([yc_mla, yc_lru, yc_ret], axis=-1) @ w_out[l]
            hc = layer_norm(ALPHA * hc + gtc * yc, ln_g[l], ln_b[l])
        h = h_new
    return h
```

```cpp
#include <hip/hip_runtime.h>
#include <cstdio>
#include <cstdint>

#define LAS __attribute__((address_space(3)))
typedef unsigned short bf16_t;
typedef short bf16x8 __attribute__((ext_vector_type(8)));
typedef float f32x4 __attribute__((ext_vector_type(4)));
typedef float f32x2 __attribute__((ext_vector_type(2)));
typedef unsigned u32x4 __attribute__((ext_vector_type(4)));
typedef unsigned u32x2 __attribute__((ext_vector_type(2)));

constexpr int DM = 2048, NBATCH = 4, SEQ = 2048, CTXL = 256, SROW = SEQ + CTXL, MROWS = NBATCH * SROW, DEPTH = 4;
constexpr int MIX_IN = 4928, NU = 5120;
constexpr int NQ = 1536, NKV = 2048;
constexpr int U_QLAT = 0, U_KVLAT = 512, U_GMLA = 768, U_LRUX = 1792, U_LRUG = 2304, U_RQ = 2816, U_RK = 3328, U_RV = 3840, U_RG = 4352, U_KR = 4864;
constexpr float LN_EPS = 1e-5f, RMS_EPS = 1e-6f;
constexpr float ALPHA = 1.681792830507429f;
constexpr float MLA_SCALE = 0.07216878364870322f;
constexpr float RET_K_SCALE = 0.08838834764831845f;

constexpr size_t MiB = 1u << 20;
constexpr size_t WS_CTL = 0, WS_ROPE = 1 * MiB, WS_MOD = 2 * MiB, WS_RSTD = 3 * MiB;
constexpr size_t WS_WIN = 4 * MiB, WS_WUQ = 84 * MiB, WS_WUKV = 90 * MiB, WS_WOUT = 94 * MiB;
constexpr size_t WS_HRES = 128 * MiB, WS_HMOD = 200 * MiB, WS_U = 236 * MiB, WS_Q = 326 * MiB, WS_KV = 353 * MiB, WS_Y = 389 * MiB;
constexpr size_t WS_LRUA = 425 * MiB, WS_LRUB = 461 * MiB, WS_END = 497 * MiB;

struct Params {
    const float *x, *c, *ctx, *c_ctx, *w_ada, *b_ada, *w_in, *q_norm_g, *kv_norm_g, *w_uq, *w_ukv;
    const float *conv_w, *conv_b, *w_r, *b_r, *w_i, *b_i, *lam, *ret_decay, *w_out, *ln_g, *ln_b;
    float* out; unsigned char* ws;
};

__device__ __forceinline__ float bf2f(bf16_t v) { return __uint_as_float(((unsigned)v) << 16); }
__device__ __forceinline__ unsigned f2bf(float f) { unsigned u = __float_as_uint(f); return (u + 0x7fffu + ((u >> 16) & 1u)) >> 16; }
__device__ __forceinline__ unsigned pk2(float lo, float hi) { return f2bf(lo) | (f2bf(hi) << 16); }
__device__ __forceinline__ float silu_f(float v) { return v / (1.0f + __expf(-v)); }
__device__ __forceinline__ float wave_sum(float v) {
#pragma unroll
    for (int o = 1; o < 64; o <<= 1) v += __shfl_xor(v, o);
    return v;
}
__device__ __forceinline__ float wave_max(float v) {
#pragma unroll
    for (int o = 1; o < 64; o <<= 1) v = fmaxf(v, __shfl_xor(v, o));
    return v;
}

__host__ __device__ __forceinline__ int win_src_col(int n) {
    if (n < 768) return n;
    if (n < 1792) return 832 + (n - 768);
    if (n < 2304) return 1856 + (n - 1792);
    if (n < 2816) return 2368 + (n - 2304);
    if (n < 3840) { const int isk = n >= 3328, base = isk ? 3328 : 2816, hh = (n - base) >> 7, p = (n - base) & 127;
        const int a = p >> 6, ihi = (p >> 5) & 1, pr = (p >> 4) & 1, ilo = p & 15, e = 64 * a + 32 * pr + 16 * ihi + ilo;
        return (isk ? 3392 : 2880) + hh * 128 + e; }
    if (n < 4352) return 3904 + (n - 3840);
    if (n < 4864) return 4416 + (n - 4352);
    if (n < 4928) return 768 + (n - 4864);
    return -1;
}

namespace pg8 {
constexpr int BM = 256, BK = 64, HALF = 128, HTB = HALF * BK * 2, STAGE_BYTES = 8 * HTB, NXCD = 8, WGM = 8;
__host__ __device__ __forceinline__ int lds_byte(int r, int c) { const int st = (r >> 4) * 2 + (c >> 5), rr = r & 15, cc = c & 31, ob = rr * 64 + cc * 2; return st * 1024 + (ob ^ (((ob >> 9) & 1) << 5)); }
__host__ __device__ __forceinline__ void stage_rc(int b, int& R, int& C) { const int st = b / 1024, sb = b % 1024, swz = sb ^ (((sb >> 9) & 1) << 5); R = (st >> 1) * 16 + swz / 64; C = (st & 1) * 32 + (swz % 64) / 2; }
struct Unit { int pm, pn; };
struct Gemm { const bf16_t* A; const bf16_t* Bt; int lda, ldb, K, pad; };
struct StaticOrder {
    int nM, nN, nwg, G, c, skip;
    __host__ __device__ void init(int nM_, int nN_, int G_, int c_, int skip_) { nM = nM_; nN = nN_; nwg = nM * nN; G = G_; c = c_; skip = skip_; }
    __host__ __device__ bool next(int i, Unit& u) const {
        const long L = (long)i * G + c; if (L >= nwg) return false;
        int wgid = (int)L; { const int q = nwg / NXCD, r = nwg % NXCD, xcd = wgid % NXCD, off = wgid / NXCD; wgid = (xcd < r ? xcd * (q + 1) : r * (q + 1) + (xcd - r) * q) + off; }
        const int nig = WGM * nN, gid = wgid / nig, fm = gid * WGM, gsz = (nM - fm) < WGM ? (nM - fm) : WGM;
        u.pm = fm + ((wgid % nig) % gsz); u.pn = (wgid % nig) / gsz;
        if (skip) u.pm += u.pm / 8 + 1;
        return true;
    }
};

template <class Epi>
__device__ __forceinline__ void gemm_phase(LAS unsigned char* lds, const Gemm g, const StaticOrder& S, const Epi& E) {
    const int tid = threadIdx.x, wid = __builtin_amdgcn_readfirstlane(tid >> 6), lane = tid & 63, wr = wid >> 2, wc = wid & 3, fr = lane & 15, fq = lane >> 4;
    const int K = g.K, nt = K / BK;
    unsigned voffA[2], voffB[2];
#pragma unroll
    for (int i = 0; i < 2; ++i) { int R, C; stage_rc(tid * 16 + i * 8192, R, C);
        voffA[i] = (unsigned)(R * g.lda + C) * 2u; voffB[i] = (unsigned)(R * g.ldb + C) * 2u; }
    const size_t kstep = (size_t)(BK * 2);
    const size_t hstepA = (size_t)HALF * g.lda * 2, hstepB = (size_t)HALF * g.ldb * 2;
    const size_t tstepA = 2 * hstepA, tstepB = 2 * hstepB;
    const unsigned ldsw = (unsigned)wid * 1024u;
    const int aoff = lds_byte(wr * 64 + fr, fq * 8), boff = lds_byte(wc * 32 + fr, fq * 8);
#define PG8_SA(b, h) (((b) * 2 + (h)) * HTB)
#define PG8_SB(b, h) ((4 + (b) * 2 + (h)) * HTB)
#define PG8_STAGE(bufoff, gbase, voff) do { _Pragma("unroll") for (int _i = 0; _i < 2; ++_i) \
        __builtin_amdgcn_global_load_lds((const unsigned*)((const char*)(gbase) + (voff)[_i]), (LAS unsigned*)(lds + (bufoff) + ldsw + _i * 8192), 16, 0, 0); } while (0)
#define PG8_LDA(dst, b, h) do { _Pragma("unroll") for (int m = 0; m < 4; ++m) _Pragma("unroll") for (int k = 0; k < 2; ++k) dst[m][k] = *(const LAS bf16x8*)(lds + PG8_SA(b, h) + aoff + m * 2048 + k * 1024); } while (0)
#define PG8_LDB(dst, b, h) do { _Pragma("unroll") for (int n = 0; n < 2; ++n) _Pragma("unroll") for (int k = 0; k < 2; ++k) dst[n][k] = *(const LAS bf16x8*)(lds + PG8_SB(b, h) + boff + n * 2048 + k * 1024); } while (0)
#define PG8_MMA(ai, bj, At, Bt) do { __builtin_amdgcn_s_setprio(1); _Pragma("unroll") for (int m = 0; m < 4; ++m) _Pragma("unroll") for (int n = 0; n < 2; ++n) _Pragma("unroll") for (int k = 0; k < 2; ++k) \
        acc[ai][bj][m][n] = __builtin_amdgcn_mfma_f32_16x16x32_bf16(Bt[n][k], At[m][k], acc[ai][bj][m][n], 0, 0, 0); __builtin_amdgcn_s_setprio(0); } while (0)
#define PG8_WAIT_V(n) asm volatile("s_waitcnt vmcnt(" #n ")" ::: "memory")
#define PG8_WAIT_L(n) asm volatile("s_waitcnt lgkmcnt(" #n ")" ::: "memory")
#define PG8_BAR __builtin_amdgcn_s_barrier()
#define PG8_SCHED __builtin_amdgcn_sched_barrier(0)
    Unit cur, nxt; int ui = 0;
    if (!S.next(0, cur)) return;
    f32x4 acc[2][2][4][2];
#pragma unroll
    for (int a = 0; a < 2; ++a)
#pragma unroll
        for (int b = 0; b < 2; ++b)
#pragma unroll
            for (int m = 0; m < 4; ++m)
#pragma unroll
                for (int n = 0; n < 2; ++n) acc[a][b][m][n] = (f32x4){0.f, 0.f, 0.f, 0.f};
    bf16x8 At[4][2], B0[2][2], B1[2][2];
    const char* cA = (const char*)g.A + (size_t)cur.pm * tstepA; const char* cB = (const char*)g.Bt + (size_t)cur.pn * tstepB;
    PG8_STAGE(PG8_SB(0, 0), cB, voffB); PG8_STAGE(PG8_SB(0, 1), cB + hstepB, voffB); PG8_STAGE(PG8_SA(0, 0), cA, voffA); PG8_STAGE(PG8_SA(0, 1), cA + hstepA, voffA);
    if (wr == 1) PG8_BAR;
    PG8_WAIT_V(2); PG8_BAR;
    PG8_STAGE(PG8_SB(1, 0), cB + kstep, voffB); PG8_STAGE(PG8_SA(1, 0), cA + kstep, voffA); PG8_STAGE(PG8_SB(1, 1), cB + hstepB + kstep, voffB);
    PG8_WAIT_V(6); PG8_BAR;
    for (;;) {
        const bool has_next = S.next(ui + 1, nxt);
        const char* nA = has_next ? (const char*)g.A + (size_t)nxt.pm * tstepA : cA; const char* nB = has_next ? (const char*)g.Bt + (size_t)nxt.pn * tstepB : cB;
        for (int t = 0; t < nt; t += 2) {
            const bool last = (t == nt - 2);
            const char* a1 = cA + (size_t)(t + 1) * kstep;
            const char* a2 = last ? nA : cA + (size_t)(t + 2) * kstep; const char* b2 = last ? nB : cB + (size_t)(t + 2) * kstep;
            const char* a3 = a2 + kstep; const char* b3 = b2 + kstep;
            PG8_LDB(B0, 0, 0); PG8_LDB(B1, 0, 1); PG8_SCHED; PG8_LDA(At, 0, 0); PG8_STAGE(PG8_SA(1, 1), a1 + hstepA, voffA);
            PG8_WAIT_V(8); PG8_WAIT_L(0); PG8_BAR; PG8_MMA(0, 0, At, B0); PG8_MMA(0, 1, At, B1); PG8_BAR; PG8_SCHED;
            PG8_LDA(At, 0, 1); PG8_STAGE(PG8_SB(0, 0), b2, voffB); PG8_STAGE(PG8_SB(0, 1), b2 + hstepB, voffB); PG8_STAGE(PG8_SA(0, 0), a2, voffA);
            PG8_WAIT_V(8); PG8_WAIT_L(0); PG8_BAR; PG8_MMA(1, 0, At, B0); PG8_MMA(1, 1, At, B1); PG8_BAR; PG8_SCHED;
            PG8_LDB(B0, 1, 0); PG8_LDB(B1, 1, 1); PG8_SCHED; PG8_LDA(At, 1, 0); PG8_STAGE(PG8_SA(0, 1), a2 + hstepA, voffA);
            PG8_WAIT_V(8); PG8_WAIT_L(0); PG8_BAR; PG8_MMA(0, 0, At, B0); PG8_MMA(0, 1, At, B1); PG8_BAR; PG8_SCHED;
            PG8_LDA(At, 1, 1); PG8_STAGE(PG8_SB(1, 0), b3, voffB); PG8_STAGE(PG8_SB(1, 1), b3 + hstepB, voffB); PG8_STAGE(PG8_SA(1, 0), a3, voffA);
            PG8_WAIT_V(8); PG8_WAIT_L(0); PG8_BAR; PG8_MMA(1, 0, At, B0); PG8_MMA(1, 1, At, B1); PG8_BAR; PG8_SCHED;
        }
        if (wr == 0) PG8_BAR;
        E(acc, cur, wr, wc, fr, fq);
        if (!has_next) break;
#pragma unroll
        for (int a = 0; a < 2; ++a)
#pragma unroll
            for (int b = 0; b < 2; ++b)
#pragma unroll
                for (int m = 0; m < 4; ++m)
#pragma unroll
                    for (int n = 0; n < 2; ++n) acc[a][b][m][n] = (f32x4){0.f, 0.f, 0.f, 0.f};
        cur = nxt; cA = nA; cB = nB; ++ui;
        if (wr == 1) PG8_BAR;
    }
    PG8_WAIT_V(0);
    PG8_BAR;
#undef PG8_SA
#undef PG8_SB
#undef PG8_STAGE
#undef PG8_LDA
#undef PG8_LDB
#undef PG8_MMA
#undef PG8_WAIT_V
#undef PG8_WAIT_L
#undef PG8_BAR
#undef PG8_SCHED
}

struct EpiPlain {
    bf16_t* O; const float* rs; int ldc, rs_stride;
    __device__ __forceinline__ void operator()(const f32x4 (&acc)[2][2][4][2], const Unit& u, int wr, int wc, int fr, int fq) const {
#pragma unroll
        for (int ai = 0; ai < 2; ++ai)
#pragma unroll
            for (int m = 0; m < 4; ++m) {
                const int row = u.pm * BM + ai * HALF + wr * 64 + m * 16 + fr;
                const float sc = rs ? rs[(size_t)row * rs_stride] : 1.f;
                bf16_t* rowp = O + (size_t)row * ldc + u.pn * BM + wc * 32 + 4 * fq;
#pragma unroll
                for (int bj = 0; bj < 2; ++bj)
#pragma unroll
                    for (int n = 0; n < 2; ++n) { const f32x4 v = acc[ai][bj][m][n] * sc; u32x2 w; w.x = pk2(v[0], v[1]); w.y = pk2(v[2], v[3]);
                        *(u32x2*)(rowp + bj * HALF + n * 16) = w; }
            }
    }
};
struct EpiResid {
    float* H; const float* modl;
    __device__ __forceinline__ void operator()(const f32x4 (&acc)[2][2][4][2], const Unit& u, int wr, int wc, int fr, int fq) const {
        const int b = u.pm / 9, cond = (u.pm % 9 == 0) ? 4 : b;
        const float* gt = modl + cond * 6144 + 4096;
        const int col0 = u.pn * BM + wc * 32 + 4 * fq;
#pragma unroll
        for (int bj = 0; bj < 2; ++bj)
#pragma unroll
            for (int n = 0; n < 2; ++n) { const f32x4 g4 = *(const f32x4*)(gt + col0 + bj * HALF + n * 16);
#pragma unroll
                for (int ai = 0; ai < 2; ++ai)
#pragma unroll
                    for (int m = 0; m < 4; ++m) { const int row = u.pm * BM + ai * HALF + wr * 64 + m * 16 + fr;
                        float* p = H + (size_t)row * DM + col0 + bj * HALF + n * 16; const f32x4 h = *(const f32x4*)p;
                        *(f32x4*)p = h * ALPHA + g4 * acc[ai][bj][m][n]; } }
    }
};
}

template <class Epi>
__global__ void __launch_bounds__(512, 2) gemm_kernel(pg8::Gemm g, int nM, int nN, int skip, Epi E) {
    extern __shared__ __attribute__((aligned(16))) unsigned char lds[];
    pg8::StaticOrder S; S.init(nM, nN, gridDim.x, blockIdx.x, skip);
    pg8::gemm_phase<Epi>((LAS unsigned char*)lds, g, S, E);
}

__device__ __forceinline__ void transpose_item(const float* W, int K, int Nsrc, int Ndst, bf16_t* WT, int colmode, const float* kscale, LAS float* scr, int item, int lane) {
    const int nblk = Ndst / 32, kb = item / nblk, nb = item % nblk, k0 = 64 * kb, n0 = 32 * nb;
    const int n = n0 + (lane & 31); const int sc = colmode ? win_src_col(n) : n;
#pragma unroll 8
    for (int i = 0; i < 32; ++i) { const int kk = 2 * i + (lane >> 5); float v = sc >= 0 ? W[(size_t)(k0 + kk) * Nsrc + sc] : 0.f; if (kscale) v *= kscale[k0 + kk]; scr[kk * 33 + (lane & 31)] = v; }
    asm volatile("s_waitcnt lgkmcnt(0)" ::: "memory");
    const int c = lane & 7;
#pragma unroll
    for (int j = 0; j < 4; ++j) { const int nn = (lane >> 3) + 8 * j; const LAS float* s = scr + (8 * c) * 33 + nn;
        u32x4 o; o.x = pk2(s[0 * 33], s[1 * 33]); o.y = pk2(s[2 * 33], s[3 * 33]); o.z = pk2(s[4 * 33], s[5 * 33]); o.w = pk2(s[6 * 33], s[7 * 33]);
        *(u32x4*)(WT + (size_t)(n0 + nn) * K + k0 + 8 * c) = o; }
    asm volatile("s_waitcnt lgkmcnt(0)" ::: "memory");
}

__device__ __forceinline__ void sincos_d(float xf, float& s, float& c) {
    const double x = (double)xf; const double kq = rint(x * 0.63661977236758134308); const double r = x - kq * 1.57079632679489661923;
    const double r2 = r * r;
    const double sp = r * (1.0 + r2 * (-1.0 / 6 + r2 * (1.0 / 120 + r2 * (-1.0 / 5040 + r2 * (1.0 / 362880 + r2 * (-1.0 / 39916800 + r2 * (1.0 / 6227020800.0)))))));
    const double cp = 1.0 + r2 * (-0.5 + r2 * (1.0 / 24 + r2 * (-1.0 / 720 + r2 * (1.0 / 40320 + r2 * (-1.0 / 3628800 + r2 * (1.0 / 479001600.0))))));
    const int q = ((int)kq) & 3;
    const double ss = (q == 0) ? sp : (q == 1) ? cp : (q == 2) ? -sp : -cp;
    const double cc = (q == 0) ? cp : (q == 1) ? -sp : (q == 2) ? -cp : sp;
    s = (float)ss; c = (float)cc;
}

__global__ void __launch_bounds__(512) prep_kernel(Params p) {
    extern __shared__ __attribute__((aligned(16))) unsigned char lds[];
    const int tid = threadIdx.x, lane = tid & 63, wave = tid >> 6;
    LAS float* scr = (LAS float*)lds + wave * (64 * 33);
    const int gw = blockIdx.x * 8 + wave, NGW = gridDim.x * 8;
    { const int gt = blockIdx.x * 512 + tid; if (gt < 64 * 32) { const int pos = gt >> 5, fi = gt & 31;
        const float inv = exp2f(-(float)fi * (13.287712379549449f / 32.0f)); const float ang = (float)pos * inv; float s, c; sincos_d(ang, s, c);
        ((f32x2*)(p.ws + WS_ROPE))[gt] = (f32x2){c, s}; } }
    constexpr int I_IN = (DM / 64) * (NU / 32), I_UQ = (512 / 64) * (NQ / 32), I_UKV = (256 / 64) * (NKV / 32), I_OUT = (DM / 64) * (DM / 32), I_L = I_IN + I_UQ + I_UKV + I_OUT;
    for (int it = gw; it < DEPTH * I_L; it += NGW) {
        const int l = it / I_L; int r = it % I_L;
        if (r < I_IN) { transpose_item(p.w_in + (size_t)l * DM * MIX_IN, DM, MIX_IN, NU, (bf16_t*)(p.ws + WS_WIN) + (size_t)l * NU * DM, 1, nullptr, scr, r, lane); continue; } r -= I_IN;
        if (r < I_UQ) { transpose_item(p.w_uq + (size_t)l * 512 * NQ, 512, NQ, NQ, (bf16_t*)(p.ws + WS_WUQ) + (size_t)l * NQ * 512, 0, p.q_norm_g + l * 512, scr, r, lane); continue; } r -= I_UQ;
        if (r < I_UKV) { transpose_item(p.w_ukv + (size_t)l * 256 * NKV, 256, NKV, NKV, (bf16_t*)(p.ws + WS_WUKV) + (size_t)l * NKV * 256, 0, p.kv_norm_g + l * 256, scr, r, lane); continue; } r -= I_UKV;
        transpose_item(p.w_out + (size_t)l * DM * DM, DM, DM, DM, (bf16_t*)(p.ws + WS_WOUT) + (size_t)l * DM * DM, 0, nullptr, scr, r, lane);
    }
}

__global__ void __launch_bounds__(512) ada_kernel(Params p) {
    extern __shared__ __attribute__((aligned(16))) unsigned char lds[];
    LAS float* sc = (LAS float*)lds;
    LAS float* red = sc + 5 * DM;
    const int tid = threadIdx.x, lane = tid & 63, wave = tid >> 6;
    for (int i = tid; i < 5 * DM; i += 512) { const float v = i < 4 * DM ? p.c[i] : p.c_ctx[i - 4 * DM]; sc[i] = silu_f(v); }
    __syncthreads();
    float* mod = (float*)(p.ws + WS_MOD);
    for (int unit = blockIdx.x; unit < DEPTH * 96; unit += gridDim.x) {
        const int l = unit / 96, col = (unit % 96) * 64 + lane;
        const float* w = p.w_ada + (size_t)l * DM * 6144 + col;
        float a0 = 0, a1 = 0, a2 = 0, a3 = 0, a4 = 0;
#pragma unroll 8
        for (int kk = 0; kk < 256; ++kk) { const int k = wave * 256 + kk; const float wv = w[(size_t)k * 6144];
            a0 += sc[k] * wv; a1 += sc[DM + k] * wv; a2 += sc[2 * DM + k] * wv; a3 += sc[3 * DM + k] * wv; a4 += sc[4 * DM + k] * wv; }
        red[(wave * 5 + 0) * 64 + lane] = a0; red[(wave * 5 + 1) * 64 + lane] = a1; red[(wave * 5 + 2) * 64 + lane] = a2; red[(wave * 5 + 3) * 64 + lane] = a3; red[(wave * 5 + 4) * 64 + lane] = a4;
        __syncthreads();
        if (wave < 5) { float s = 0; for (int w8 = 0; w8 < 8; ++w8) s += red[(w8 * 5 + wave) * 64 + lane];
            mod[((size_t)l * 5 + wave) * 6144 + col] = s + p.b_ada[l * 6144 + col]; }
        __syncthreads();
    }
}

__device__ __forceinline__ void ln_row(const float* src, const float* g, const float* b, float* dst, bf16_t* hm, const float* modc, int lane) {
    f32x4 v[8]; float s = 0.f;
#pragma unroll
    for (int j = 0; j < 8; ++j) { v[j] = *(const f32x4*)(src + j * 256 + lane * 4); s += (v[j][0] + v[j][1]) + (v[j][2] + v[j][3]); }
    const float mean = wave_sum(s) * (1.f / DM); float s2 = 0.f;
#pragma unroll
    for (int j = 0; j < 8; ++j) { v[j] = v[j] - mean; s2 += (v[j][0] * v[j][0] + v[j][1] * v[j][1]) + (v[j][2] * v[j][2] + v[j][3] * v[j][3]); }
    const float rstd = 1.f / sqrtf(wave_sum(s2) * (1.f / DM) + LN_EPS);
#pragma unroll
    for (int j = 0; j < 8; ++j) { const int c = j * 256 + lane * 4; f32x4 y = v[j] * rstd;
        if (g) { y = y * *(const f32x4*)(g + c) + *(const f32x4*)(b + c); }
        if (dst) *(f32x4*)(dst + c) = y;
        if (hm) { const f32x4 sh = *(const f32x4*)(modc + c), scl = *(const f32x4*)(modc + 2048 + c); const f32x4 z = y * (scl + 1.0f) + sh;
            u32x2 w; w.x = pk2(z[0], z[1]); w.y = pk2(z[2], z[3]); *(u32x2*)(hm + c) = w; } }
}
__global__ void __launch_bounds__(512) ln_kernel(Params p, int layer) {
    const int lane = threadIdx.x & 63, gw = blockIdx.x * 8 + (threadIdx.x >> 6), NGW = gridDim.x * 8;
    float* hres = (float*)(p.ws + WS_HRES); bf16_t* hmod = (bf16_t*)(p.ws + WS_HMOD); const float* mod = (const float*)(p.ws + WS_MOD);
    for (int row = gw; row < MROWS; row += NGW) {
        const int b = row / SROW, s = row % SROW, isctx = s < CTXL, cond = isctx ? 4 : b;
        if (layer < 0) { const float* src = isctx ? p.ctx + ((size_t)b * CTXL + s) * DM : p.x + ((size_t)b * SEQ + (s - CTXL)) * DM;
            ln_row(src, nullptr, nullptr, hres + (size_t)row * DM, hmod + (size_t)row * DM, mod + (size_t)(0 * 5 + cond) * 6144, lane); }
        else if (layer < DEPTH - 1) ln_row(hres + (size_t)row * DM, p.ln_g + layer * DM, p.ln_b + layer * DM, hres + (size_t)row * DM, hmod + (size_t)row * DM, mod + (size_t)((layer + 1) * 5 + cond) * 6144, lane);
        else if (!isctx) ln_row(hres + (size_t)row * DM, p.ln_g + layer * DM, p.ln_b + layer * DM, p.out + ((size_t)b * SEQ + (s - CTXL)) * DM, nullptr, nullptr, lane);
    }
}

__device__ __forceinline__ void in_transform(int row, int c0, f32x4& v0, f32x4& v1, const f32x2* cs) {
    const int s = row % SROW; const bool lat = s >= CTXL; const int t = s - CTXL;
    if (c0 < U_GMLA) return;
    if (c0 < U_LRUX || (c0 >= U_LRUG && c0 < U_RQ) || (c0 >= U_RG && c0 < U_KR)) {
#pragma unroll
        for (int j = 0; j < 4; ++j) { v0[j] = silu_f(v0[j]); v1[j] = silu_f(v1[j]); }
        return; }
    if (c0 >= U_RQ && c0 < U_RV) {
        const bool isk = c0 >= U_RK; const int pp = (c0 - U_RQ) & 127;
        if (lat) { const int a = pp >> 6, i0 = ((pp >> 5) & 1) * 16 + (pp & 15), pos = a ? (t & 63) : (t >> 6);
#pragma unroll
            for (int j = 0; j < 4; ++j) { const f32x2 c = cs[pos * 32 + i0 + j]; const float x1 = v0[j], x2 = v1[j]; v0[j] = x1 * c[0] - x2 * c[1]; v1[j] = x2 * c[0] + x1 * c[1]; } }
        if (isk) { v0 = v0 * RET_K_SCALE; v1 = v1 * RET_K_SCALE; }
        return; }
    if (c0 >= U_KR && c0 < U_KR + 64) {
        if (lat) { const int e = c0 - U_KR, a = e >> 5, i0 = e & 15, pos = a ? (t & 63) : (t >> 6);
#pragma unroll
            for (int j = 0; j < 4; ++j) { const f32x2 c = cs[pos * 32 + 2 * (i0 + j)]; const float x1 = v0[j], x2 = v1[j]; v0[j] = x1 * c[0] - x2 * c[1]; v1[j] = x2 * c[0] + x1 * c[1]; } }
        return; }
}
__device__ __forceinline__ f32x4 ld4bf(const bf16_t* p) { const u32x2 w = *(const u32x2*)p; return (f32x4){__uint_as_float(w.x << 16), __uint_as_float(w.x & 0xffff0000u), __uint_as_float(w.y << 16), __uint_as_float(w.y & 0xffff0000u)}; }
__device__ __forceinline__ void st4bf(bf16_t* p, f32x4 v) { u32x2 w; w.x = pk2(v[0], v[1]); w.y = pk2(v[2], v[3]); *(u32x2*)p = w; }

__global__ void __launch_bounds__(256) u_fix_kernel(Params p) {
    bf16_t* U = (bf16_t*)(p.ws + WS_U); const f32x2* cs = (const f32x2*)(p.ws + WS_ROPE);
    const long total = (long)MROWS * (NU / 8);
    for (long i = blockIdx.x * 256L + threadIdx.x; i < total; i += gridDim.x * 256L) {
        const int row = (int)(i / (NU / 8)), un = (int)(i % (NU / 8)); const int c0 = (un >> 2) * 32 + (un & 3) * 4;
        if (c0 < U_GMLA) continue;
        bf16_t* q = U + (size_t)row * NU + c0; f32x4 v0 = ld4bf(q), v1 = ld4bf(q + 16);
        in_transform(row, c0, v0, v1, cs); st4bf(q, v0); st4bf(q + 16, v1);
    }
}
__global__ void __launch_bounds__(256) rstd_kernel(Params p) {
    const bf16_t* U = (const bf16_t*)(p.ws + WS_U); float* rs = (float*)(p.ws + WS_RSTD);
    const int lane = threadIdx.x & 63, gw = blockIdx.x * 4 + (threadIdx.x >> 6), NGW = gridDim.x * 4;
    for (int row = gw; row < MROWS; row += NGW) {
        const bf16_t* u = U + (size_t)row * NU; float sq = 0.f, sk = 0.f;
        for (int j = lane; j < 512; j += 64) { const float v = bf2f(u[j]); sq += v * v; }
        for (int j = lane; j < 256; j += 64) { const float v = bf2f(u[512 + j]); sk += v * v; }
        sq = wave_sum(sq); sk = wave_sum(sk);
        if (lane == 0) { rs[row * 2] = 1.f / sqrtf(sq * (1.f / 512) + RMS_EPS); rs[row * 2 + 1] = 1.f / sqrtf(sk * (1.f / 256) + RMS_EPS); }
    }
}
__global__ void __launch_bounds__(256) q_fix_kernel(Params p) {
    bf16_t* Q = (bf16_t*)(p.ws + WS_Q); const f32x2* cs = (const f32x2*)(p.ws + WS_ROPE);
    const long total = (long)MROWS * 8 * 32;
    for (long i = blockIdx.x * 256L + threadIdx.x; i < total; i += gridDim.x * 256L) {
        const int row = (int)(i >> 8), r = (int)(i & 255), h = r >> 5, a = (r >> 4) & 1, ii = r & 15;
        const int s = row % SROW; if (s < CTXL) continue; const int t = s - CTXL, pos = a ? (t & 63) : (t >> 6);
        bf16_t* q = Q + (size_t)row * NQ + h * 192 + 128 + a * 32 + ii; const f32x2 c = cs[pos * 32 + 2 * ii];
        const float x1 = bf2f(q[0]), x2 = bf2f(q[16]); q[0] = (bf16_t)f2bf(x1 * c[0] - x2 * c[1]); q[16] = (bf16_t)f2bf(x2 * c[0] + x1 * c[1]);
    }
}

template <int MODE>
__global__ void __launch_bounds__(64) naive_mix_kernel(Params p, int layer, int do_ctx) {
    extern __shared__ __attribute__((aligned(16))) unsigned char lds[];
    constexpr int DQK = MODE == 0 ? 192 : 128, NH = MODE == 0 ? 8 : 4;
    LAS float* S = (LAS float*)lds;
    LAS float* qs = S + 4 * SROW;
    const int lane = threadIdx.x;
    const bf16_t* U = (const bf16_t*)(p.ws + WS_U); const bf16_t* Q = (const bf16_t*)(p.ws + WS_Q); const bf16_t* KV = (const bf16_t*)(p.ws + WS_KV); bf16_t* Y = (bf16_t*)(p.ws + WS_Y);
    const int ngroups = NBATCH * NH * (SROW / 4);
    for (int grp = blockIdx.x; grp < ngroups; grp += gridDim.x) {
        const int b = grp / (NH * (SROW / 4)), rem = grp % (NH * (SROW / 4)), h = rem / (SROW / 4), s0 = (rem % (SROW / 4)) * 4;
        const bool isctx = s0 < CTXL; if (isctx && !do_ctx) continue;
        const int nkeys = isctx ? CTXL : SROW; const int rowbase = b * SROW;
        float lgf = 0.f, lgb = 0.f;
        if (MODE == 1) { const float df = p.ret_decay[(layer * 2 + 0) * 4 + h], db = p.ret_decay[(layer * 2 + 1) * 4 + h]; lgf = -log1pf(expf(-df)); lgb = -log1pf(expf(-db)); }
        __syncthreads();
        for (int i = lane; i < 4 * DQK; i += 64) { const int qi = i / DQK, d = i % DQK; const int row = rowbase + s0 + qi;
            qs[i] = MODE == 0 ? bf2f(Q[(size_t)row * NQ + h * 192 + d]) : bf2f(U[(size_t)row * NU + U_RQ + h * 128 + d]); }
        __syncthreads();
        float mx[4] = {-1e30f, -1e30f, -1e30f, -1e30f};
        for (int k = lane; k < nkeys; k += 64) {
            const int krow = rowbase + k; float d0 = 0, d1 = 0, d2 = 0, d3 = 0;
            if (MODE == 0) {
                const bf16_t* kn = KV + (size_t)krow * NKV + h * 256; const bf16_t* kr = U + (size_t)krow * NU + U_KR;
                for (int d = 0; d < 128; ++d) { const float kv = bf2f(kn[d]); d0 += qs[d] * kv; d1 += qs[192 + d] * kv; d2 += qs[384 + d] * kv; d3 += qs[576 + d] * kv; }
                for (int d = 0; d < 64; ++d) { const float kv = bf2f(kr[d]); d0 += qs[128 + d] * kv; d1 += qs[192 + 128 + d] * kv; d2 += qs[384 + 128 + d] * kv; d3 += qs[576 + 128 + d] * kv; }
                d0 *= MLA_SCALE; d1 *= MLA_SCALE; d2 *= MLA_SCALE; d3 *= MLA_SCALE;
            } else {
                const bf16_t* kk = U + (size_t)krow * NU + U_RK + h * 128;
                for (int d = 0; d < 128; ++d) { const float kv = bf2f(kk[d]); d0 += qs[d] * kv; d1 += qs[128 + d] * kv; d2 += qs[256 + d] * kv; d3 += qs[384 + d] * kv; }
                float dd[4] = {d0, d1, d2, d3};
                for (int qi = 0; qi < 4; ++qi) { const int sq = s0 + qi; float w;
                    if (isctx) { const int n = sq, m = k; w = m <= n ? expf((float)(n - m) * lgf) : expf((float)(m - n) * lgb); }
                    else { const int n = sq - CTXL;
                        if (k < CTXL) w = expf((float)(n + CTXL - k) * lgf) + expf((float)(SEQ - n + k) * lgb);
                        else { const int m = k - CTXL; w = m <= n ? expf((float)(n - m) * lgf) : expf((float)(m - n) * lgb); } }
                    dd[qi] *= w; }
                d0 = dd[0]; d1 = dd[1]; d2 = dd[2]; d3 = dd[3];
            }
            S[k] = d0; S[SROW + k] = d1; S[2 * SROW + k] = d2; S[3 * SROW + k] = d3;
            mx[0] = fmaxf(mx[0], d0); mx[1] = fmaxf(mx[1], d1); mx[2] = fmaxf(mx[2], d2); mx[3] = fmaxf(mx[3], d3);
        }
        float inv[4] = {1.f, 1.f, 1.f, 1.f};
        if (MODE == 0) {
            for (int qi = 0; qi < 4; ++qi) { const float m = wave_max(mx[qi]); float sum = 0.f;
                for (int k = lane; k < nkeys; k += 64) { const float e = expf(S[qi * SROW + k] - m); S[qi * SROW + k] = e; sum += e; }
                inv[qi] = 1.f / wave_sum(sum); }
        }
        __syncthreads();
        float o[4][2] = {{0, 0}, {0, 0}, {0, 0}, {0, 0}};
        for (int k = 0; k < nkeys; ++k) {
            const int krow = rowbase + k;
            const unsigned vv = MODE == 0 ? *(const unsigned*)(KV + (size_t)krow * NKV + h * 256 + 128 + 2 * lane) : *(const unsigned*)(U + (size_t)krow * NU + U_RV + h * 128 + 2 * lane);
            const float v0 = __uint_as_float(vv << 16), v1 = __uint_as_float(vv & 0xffff0000u);
#pragma unroll
            for (int qi = 0; qi < 4; ++qi) { const float pw = S[qi * SROW + k]; o[qi][0] += pw * v0; o[qi][1] += pw * v1; }
        }
        for (int qi = 0; qi < 4; ++qi) {
            const int row = rowbase + s0 + qi; float y0 = o[qi][0] * inv[qi], y1 = o[qi][1] * inv[qi];
            if (MODE == 1) { const float mean = wave_sum(y0 + y1) * (1.f / 128); y0 -= mean; y1 -= mean; const float var = wave_sum(y0 * y0 + y1 * y1) * (1.f / 128); const float rstd = 1.f / sqrtf(var + LN_EPS); y0 *= rstd; y1 *= rstd; }
            const unsigned gg = *(const unsigned*)(U + (size_t)row * NU + (MODE == 0 ? U_GMLA : U_RG) + h * 128 + 2 * lane);
            y0 *= __uint_as_float(gg << 16); y1 *= __uint_as_float(gg & 0xffff0000u);
            *(unsigned*)(Y + (size_t)row * DM + (MODE == 0 ? 0 : 1536) + h * 128 + 2 * lane) = pk2(y0, y1);
        }
    }
}

__global__ void __launch_bounds__(512) lru_ab_kernel(Params p, int layer) {
    __shared__ float xl[512];
    const bf16_t* U = (const bf16_t*)(p.ws + WS_U); float* A = (float*)(p.ws + WS_LRUA); float* Bc = (float*)(p.ws + WS_LRUB);
    const int ch = threadIdx.x, g = ch >> 6, j = ch & 63;
    for (int row = blockIdx.x; row < MROWS; row += gridDim.x) {
        const int s = row % SROW; const int lo = s < CTXL ? 0 : CTXL, hi = s < CTXL ? CTXL : SROW;
        float acc = p.conv_b[layer * 512 + ch];
#pragma unroll
        for (int k = 0; k < 4; ++k) { const int ss = s + k - 2; if (ss >= lo && ss < hi) acc += bf2f(U[(size_t)(row + k - 2) * NU + U_LRUX + ch]) * p.conv_w[(layer * 4 + k) * 512 + ch]; }
        __syncthreads();
        xl[ch] = acc;
        __syncthreads();
#pragma unroll 1
        for (int d = 0; d < 2; ++d) {
            const float* wr = p.w_r + ((size_t)((layer * 2 + d) * 8 + g) * 64) * 64 + j; const float* wi = p.w_i + ((size_t)((layer * 2 + d) * 8 + g) * 64) * 64 + j;
            float r = p.b_r[(layer * 2 + d) * 512 + ch], ig = p.b_i[(layer * 2 + d) * 512 + ch];
#pragma unroll 4
            for (int i = 0; i < 64; ++i) { const float xv = xl[g * 64 + i]; r += xv * wr[i * 64]; ig += xv * wi[i * 64]; }
            r = 1.f / (1.f + expf(-r)); ig = 1.f / (1.f + expf(-ig));
            const float lm = p.lam[(layer * 2 + d) * 512 + ch]; const float sp = log1pf(expf(-lm));
            const float log_a = -8.0f * r * sp; const float a = expf(log_a); const float mult = sqrtf(-expm1f(2.0f * log_a));
            A[((size_t)d * MROWS + row) * 512 + ch] = a; Bc[((size_t)d * MROWS + row) * 512 + ch] = mult * (ig * acc);
        }
    }
}
__global__ void __launch_bounds__(64) lru_scan_kernel(Params p) {
    const float* A = (const float*)(p.ws + WS_LRUA); float* Bc = (float*)(p.ws + WS_LRUB);
    const int id = blockIdx.x * 64 + threadIdx.x; if (id >= NBATCH * 2 * 512) return;
    const int ch = id & 511, d = (id >> 9) & 1, b = id >> 10;
    const size_t base = ((size_t)d * MROWS + (size_t)b * SROW) * 512 + ch;
    float h = 0.f;
    if (d == 0) { for (int s = 0; s < SROW; ++s) { const size_t o = base + (size_t)s * 512; h = A[o] * h + Bc[o]; Bc[o] = h; } }
    else { for (int s = CTXL - 1; s >= 0; --s) { const size_t o = base + (size_t)s * 512; h = A[o] * h + Bc[o]; Bc[o] = h; }
           for (int s = SROW - 1; s >= CTXL; --s) { const size_t o = base + (size_t)s * 512; h = A[o] * h + Bc[o]; Bc[o] = h; } }
}
__global__ void __launch_bounds__(256) lru_out_kernel(Params p) {
    const float* H = (const float*)(p.ws + WS_LRUB); const bf16_t* U = (const bf16_t*)(p.ws + WS_U); bf16_t* Y = (bf16_t*)(p.ws + WS_Y);
    const long total = (long)MROWS * 512;
    for (long i = blockIdx.x * 256L + threadIdx.x; i < total; i += gridDim.x * 256L) {
        const int row = (int)(i >> 9), ch = (int)(i & 511);
        const float v = (H[i] + H[(size_t)MROWS * 512 + i]) * bf2f(U[(size_t)row * NU + U_LRUG + ch]);
        Y[(size_t)row * DM + 1024 + ch] = (bf16_t)f2bf(v);
    }
}

extern "C" void kernel_launch(void* const* d_in, const int* in_sizes, int n_in, void* d_out, int out_size, void* d_ws, size_t ws_size, hipStream_t stream) {
    static int ok = 0;
    if (ok == 0) {
        if (n_in != 22 || in_sizes[0] != NBATCH * SEQ * DM || out_size != NBATCH * SEQ * DM || ws_size < WS_END) {
            fprintf(stderr, "kernel_launch: unexpected shapes: n_in %d in0 %d out %d ws %zu (need %zu)\n", n_in, n_in > 0 ? in_sizes[0] : -1, out_size, ws_size, (size_t)WS_END); ok = -1; return; }
        hipFuncSetAttribute((const void*)gemm_kernel<pg8::EpiPlain>, hipFuncAttributeMaxDynamicSharedMemorySize, 131072);
        hipFuncSetAttribute((const void*)gemm_kernel<pg8::EpiResid>, hipFuncAttributeMaxDynamicSharedMemorySize, 131072);
        hipFuncSetAttribute((const void*)prep_kernel, hipFuncAttributeMaxDynamicSharedMemorySize, 8 * 64 * 33 * 4);
        hipFuncSetAttribute((const void*)ada_kernel, hipFuncAttributeMaxDynamicSharedMemorySize, (5 * DM + 8 * 5 * 64) * 4);
        hipFuncSetAttribute((const void*)naive_mix_kernel<0>, hipFuncAttributeMaxDynamicSharedMemorySize, (4 * SROW + 4 * 192) * 4);
        hipFuncSetAttribute((const void*)naive_mix_kernel<1>, hipFuncAttributeMaxDynamicSharedMemorySize, (4 * SROW + 4 * 192) * 4);
        ok = 1;
    }
    if (ok < 0) return;
    Params p{};
    const float** f = (const float**)&p;
    for (int i = 0; i < 22; ++i) f[i] = (const float*)d_in[i];
    p.out = (float*)d_out; p.ws = (unsigned char*)d_ws;
    unsigned char* ws = p.ws;
    prep_kernel<<<256, 512, 8 * 64 * 33 * 4, stream>>>(p);
    ada_kernel<<<256, 512, (5 * DM + 8 * 5 * 64) * 4, stream>>>(p);
    ln_kernel<<<256, 512, 0, stream>>>(p, -1);
    for (int l = 0; l < DEPTH; ++l) {
        const int last = (l == DEPTH - 1);
        { pg8::Gemm g{(const bf16_t*)(ws + WS_HMOD), (const bf16_t*)(ws + WS_WIN) + (size_t)l * NU * DM, DM, DM, DM, 0};
          pg8::EpiPlain E{(bf16_t*)(ws + WS_U), nullptr, NU, 0};
          gemm_kernel<pg8::EpiPlain><<<256, 512, 131072, stream>>>(g, 36, NU / 256, 0, E); }
        rstd_kernel<<<1024, 256, 0, stream>>>(p);
        u_fix_kernel<<<2048, 256, 0, stream>>>(p);
        { pg8::Gemm g{(const bf16_t*)(ws + WS_U) + U_QLAT, (const bf16_t*)(ws + WS_WUQ) + (size_t)l * NQ * 512, NU, 512, 512, 0};
          pg8::EpiPlain E{(bf16_t*)(ws + WS_Q), (const float*)(ws + WS_RSTD), NQ, 2};
          gemm_kernel<pg8::EpiPlain><<<256, 512, 131072, stream>>>(g, last ? 32 : 36, NQ / 256, last, E); }
        q_fix_kernel<<<2048, 256, 0, stream>>>(p);
        { pg8::Gemm g{(const bf16_t*)(ws + WS_U) + U_KVLAT, (const bf16_t*)(ws + WS_WUKV) + (size_t)l * NKV * 256, NU, 256, 256, 0};
          pg8::EpiPlain E{(bf16_t*)(ws + WS_KV), (const float*)(ws + WS_RSTD) + 1, NKV, 2};
          gemm_kernel<pg8::EpiPlain><<<256, 512, 131072, stream>>>(g, 36, NKV / 256, 0, E); }
        naive_mix_kernel<0><<<4096, 64, (4 * SROW + 4 * 192) * 4, stream>>>(p, l, !last);
        naive_mix_kernel<1><<<4096, 64, (4 * SROW + 4 * 192) * 4, stream>>>(p, l, !last);
        lru_ab_kernel<<<2048, 512, 0, stream>>>(p, l);
        lru_scan_kernel<<<64, 64, 0, stream>>>(p);
        lru_out_kernel<<<2048, 256, 0, stream>>>(p);
        { pg8::Gemm g{(const bf16_t*)(ws + WS_Y), (const bf16_t*)(ws + WS_WOUT) + (size_t)l * DM * DM, DM, DM, DM, 0};
          pg8::EpiResid E{(float*)(ws + WS_HRES), (const float*)(ws + WS_MOD) + (size_t)l * 5 * 6144};
          gemm_kernel<pg8::EpiResid><<<256, 512, 131072, stream>>>(g, last ? 32 : 36, DM / 256, last, E); }
        ln_kernel<<<256, 512, 0, stream>>>(p, l);
    }
}
```

```cpp
#include <hip/hip_runtime.h>
#include <hip/hip_cooperative_groups.h>
#include <cstdio>
#include <cstdint>

#define LAS __attribute__((address_space(3)))
typedef unsigned short bf16_t;
typedef short bf16x8 __attribute__((ext_vector_type(8)));
typedef float f32x4 __attribute__((ext_vector_type(4)));
typedef float f32x2 __attribute__((ext_vector_type(2)));
typedef unsigned u32x4 __attribute__((ext_vector_type(4)));
typedef unsigned u32x2 __attribute__((ext_vector_type(2)));

constexpr int DM = 2048, NBATCH = 4, SEQ = 2048, CTXL = 256, SROW = SEQ + CTXL, MROWS = NBATCH * SROW, DEPTH = 4;
constexpr int MIX_IN = 4928, NU = 5120;
constexpr int NQ = 1536, NKV = 2048;
constexpr int U_QLAT = 0, U_KVLAT = 512, U_GMLA = 768, U_LRUX = 1792, U_LRUG = 2304, U_RQ = 2816, U_RK = 3328, U_RV = 3840, U_RG = 4352, U_KR = 4864;
constexpr float LN_EPS = 1e-5f, RMS_EPS = 1e-6f;
constexpr float ALPHA = 1.681792830507429f;
constexpr float MLA_SCALE = 0.07216878364870322f;
constexpr float RET_K_SCALE = 0.08838834764831845f;

constexpr size_t MiB = 1u << 20;
constexpr size_t WS_CTL = 0, WS_ROPE = 1 * MiB, WS_MOD = 2 * MiB, WS_RSTD = 3 * MiB;
constexpr size_t WS_WIN = 4 * MiB, WS_WUQ = 84 * MiB, WS_WUKV = 90 * MiB, WS_WOUT = 94 * MiB;
constexpr size_t WS_HRES = 128 * MiB, WS_HMOD = 200 * MiB, WS_U = 236 * MiB, WS_Q = 326 * MiB, WS_KV = 353 * MiB, WS_Y = 389 * MiB;
constexpr size_t WS_LRUA = 425 * MiB, WS_LRUB = 461 * MiB, WS_SSQ = 497 * MiB;
constexpr size_t WS_LRUW = 498 * MiB;
constexpr size_t WS_LSUM = 500 * MiB;
constexpr size_t WS_RST = 504 * MiB;
constexpr size_t WS_END = 544 * MiB;

struct Params {
    const float *x, *c, *ctx, *c_ctx, *w_ada, *b_ada, *w_in, *q_norm_g, *kv_norm_g, *w_uq, *w_ukv;
    const float *conv_w, *conv_b, *w_r, *b_r, *w_i, *b_i, *lam, *ret_decay, *w_out, *ln_g, *ln_b;
    float* out; unsigned char* ws;
};

__device__ __forceinline__ float bf2f(bf16_t v) { return __uint_as_float(((unsigned)v) << 16); }
__device__ __forceinline__ unsigned f2bf(float f) { unsigned u = __float_as_uint(f); return (u + 0x7fffu + ((u >> 16) & 1u)) >> 16; }
__device__ __forceinline__ unsigned pk2(float lo, float hi) { return f2bf(lo) | (f2bf(hi) << 16); }
__device__ __forceinline__ float silu_f(float v) { return v / (1.0f + __expf(-v)); }
__device__ __forceinline__ float wave_sum(float v) {
#pragma unroll
    for (int o = 1; o < 64; o <<= 1) v += __shfl_xor(v, o);
    return v;
}
__device__ __forceinline__ float wave_max(float v) {
#pragma unroll
    for (int o = 1; o < 64; o <<= 1) v = fmaxf(v, __shfl_xor(v, o));
    return v;
}

__host__ __device__ __forceinline__ int win_src_col(int n) {
    if (n < 768) return n;
    if (n < 1792) return 832 + (n - 768);
    if (n < 2304) return 1856 + (n - 1792);
    if (n < 2816) return 2368 + (n - 2304);
    if (n < 3840) { const int isk = n >= 3328, base = isk ? 3328 : 2816, hh = (n - base) >> 7, p = (n - base) & 127;
        const int a = p >> 6, ihi = (p >> 5) & 1, pr = (p >> 4) & 1, ilo = p & 15, e = 64 * a + 32 * pr + 16 * ihi + ilo;
        return (isk ? 3392 : 2880) + hh * 128 + e; }
    if (n < 4352) return 3904 + (n - 3840);
    if (n < 4864) return 4416 + (n - 4352);
    if (n < 4928) return 768 + (n - 4864);
    return -1;
}

__device__ __forceinline__ void in_transform(int row, int c0, f32x4& v0, f32x4& v1, const f32x2* cs) {
    const int s = row % SROW; const bool lat = s >= CTXL; const int t = s - CTXL;
    if (c0 < U_GMLA) return;
    if (c0 < U_LRUX || (c0 >= U_LRUG && c0 < U_RQ) || (c0 >= U_RG && c0 < U_KR)) {
#pragma unroll
        for (int j = 0; j < 4; ++j) { v0[j] = silu_f(v0[j]); v1[j] = silu_f(v1[j]); }
        return; }
    if (c0 >= U_RQ && c0 < U_RV) {
        const bool isk = c0 >= U_RK; const int pp = (c0 - U_RQ) & 127;
        if (lat) { const int a = pp >> 6, i0 = ((pp >> 5) & 1) * 16 + (pp & 15), pos = a ? (t & 63) : (t >> 6);
#pragma unroll
            for (int j = 0; j < 4; ++j) { const f32x2 c = cs[pos * 32 + i0 + j]; const float x1 = v0[j], x2 = v1[j]; v0[j] = x1 * c[0] - x2 * c[1]; v1[j] = x2 * c[0] + x1 * c[1]; } }
        if (isk) { v0 = v0 * RET_K_SCALE; v1 = v1 * RET_K_SCALE; }
        return; }
    if (c0 >= U_KR && c0 < U_KR + 64) {
        if (lat) { const int e = c0 - U_KR, a = e >> 5, i0 = e & 15, pos = a ? (t & 63) : (t >> 6);
#pragma unroll
            for (int j = 0; j < 4; ++j) { const f32x2 c = cs[pos * 32 + 2 * (i0 + j)]; const float x1 = v0[j], x2 = v1[j]; v0[j] = x1 * c[0] - x2 * c[1]; v1[j] = x2 * c[0] + x1 * c[1]; } }
        return; }
}
__device__ __forceinline__ f32x4 ld4bf(const bf16_t* p) { const u32x2 w = *(const u32x2*)p; return (f32x4){__uint_as_float(w.x << 16), __uint_as_float(w.x & 0xffff0000u), __uint_as_float(w.y << 16), __uint_as_float(w.y & 0xffff0000u)}; }
__device__ __forceinline__ void st4bf(bf16_t* p, f32x4 v) { u32x2 w; w.x = pk2(v[0], v[1]); w.y = pk2(v[2], v[3]); *(u32x2*)p = w; }


namespace pg8 {
constexpr int BM = 256, BK = 64, HALF = 128, HTB = HALF * BK * 2, STAGE_BYTES = 8 * HTB, NXCD = 8, WGM = 8;
__host__ __device__ __forceinline__ int lds_byte(int r, int c) { const int st = (r >> 4) * 2 + (c >> 5), rr = r & 15, cc = c & 31, ob = rr * 64 + cc * 2; return st * 1024 + (ob ^ (((ob >> 9) & 1) << 5)); }
__host__ __device__ __forceinline__ void stage_rc(int b, int& R, int& C) { const int st = b / 1024, sb = b % 1024, swz = sb ^ (((sb >> 9) & 1) << 5); R = (st >> 1) * 16 + swz / 64; C = (st & 1) * 32 + (swz % 64) / 2; }
struct Unit { int pm, pn; };
struct Gemm { const bf16_t* A; const bf16_t* Bt; int lda, ldb, K, pad; };
struct StaticOrder {
    int nM, nN, nwg, G, c, skip;
    __host__ __device__ void init(int nM_, int nN_, int G_, int c_, int skip_) { nM = nM_; nN = nN_; nwg = nM * nN; G = G_; c = c_; skip = skip_; }
    __host__ __device__ bool next(int i, Unit& u) const {
        const long L = (long)i * G + c; if (L >= nwg) return false;
        int wgid = (int)L; { const int q = nwg / NXCD, r = nwg % NXCD, xcd = wgid % NXCD, off = wgid / NXCD; wgid = (xcd < r ? xcd * (q + 1) : r * (q + 1) + (xcd - r) * q) + off; }
        const int nig = WGM * nN, gid = wgid / nig, fm = gid * WGM, gsz = (nM - fm) < WGM ? (nM - fm) : WGM;
        u.pm = fm + ((wgid % nig) % gsz); u.pn = (wgid % nig) / gsz;
        if (skip) u.pm += u.pm / 8 + 1;
        return true;
    }
};

template <class Epi>
__device__ __forceinline__ void gemm_phase(LAS unsigned char* lds, const Gemm g, const StaticOrder& S, const Epi& E) {
    const int tid = threadIdx.x, wid = __builtin_amdgcn_readfirstlane(tid >> 6), lane = tid & 63, wr = wid >> 2, wc = wid & 3, fr = lane & 15, fq = lane >> 4;
    const int K = g.K, nt = K / BK;
    unsigned voffA[2], voffB[2];
#pragma unroll
    for (int i = 0; i < 2; ++i) { int R, C; stage_rc(tid * 16 + i * 8192, R, C);
        voffA[i] = (unsigned)(R * g.lda + C) * 2u; voffB[i] = (unsigned)(R * g.ldb + C) * 2u; }
    const size_t kstep = (size_t)(BK * 2);
    const size_t hstepA = (size_t)HALF * g.lda * 2, hstepB = (size_t)HALF * g.ldb * 2;
    const size_t tstepA = 2 * hstepA, tstepB = 2 * hstepB;
    const unsigned ldsw = (unsigned)wid * 1024u;
    const int aoff = lds_byte(wr * 64 + fr, fq * 8), boff = lds_byte(wc * 32 + fr, fq * 8);
#define PG8_SA(b, h) (((b) * 2 + (h)) * HTB)
#define PG8_SB(b, h) ((4 + (b) * 2 + (h)) * HTB)
#define PG8_STAGE(bufoff, gbase, voff) do { _Pragma("unroll") for (int _i = 0; _i < 2; ++_i) \
        __builtin_amdgcn_global_load_lds((const unsigned*)((const char*)(gbase) + (voff)[_i]), (LAS unsigned*)(lds + (bufoff) + ldsw + _i * 8192), 16, 0, 0); } while (0)
#define PG8_LDA(dst, b, h) do { _Pragma("unroll") for (int m = 0; m < 4; ++m) _Pragma("unroll") for (int k = 0; k < 2; ++k) dst[m][k] = *(const LAS bf16x8*)(lds + PG8_SA(b, h) + aoff + m * 2048 + k * 1024); } while (0)
#define PG8_LDB(dst, b, h) do { _Pragma("unroll") for (int n = 0; n < 2; ++n) _Pragma("unroll") for (int k = 0; k < 2; ++k) dst[n][k] = *(const LAS bf16x8*)(lds + PG8_SB(b, h) + boff + n * 2048 + k * 1024); } while (0)
#define PG8_MMA(ai, bj, At, Bt) do { __builtin_amdgcn_s_setprio(1); _Pragma("unroll") for (int m = 0; m < 4; ++m) _Pragma("unroll") for (int n = 0; n < 2; ++n) _Pragma("unroll") for (int k = 0; k < 2; ++k) \
        acc[ai][bj][m][n] = __builtin_amdgcn_mfma_f32_16x16x32_bf16(Bt[n][k], At[m][k], acc[ai][bj][m][n], 0, 0, 0); __builtin_amdgcn_s_setprio(0); } while (0)
#define PG8_WAIT_V(n) asm volatile("s_waitcnt vmcnt(" #n ")" ::: "memory")
#define PG8_WAIT_L(n) asm volatile("s_waitcnt lgkmcnt(" #n ")" ::: "memory")
#define PG8_BAR __builtin_amdgcn_s_barrier()
#define PG8_SCHED __builtin_amdgcn_sched_barrier(0)
    Unit cur, nxt; int ui = 0;
    if (!S.next(0, cur)) return;
    f32x4 acc[2][2][4][2];
#pragma unroll
    for (int a = 0; a < 2; ++a)
#pragma unroll
        for (int b = 0; b < 2; ++b)
#pragma unroll
            for (int m = 0; m < 4; ++m)
#pragma unroll
                for (int n = 0; n < 2; ++n) acc[a][b][m][n] = (f32x4){0.f, 0.f, 0.f, 0.f};
    bf16x8 At[4][2], B0[2][2], B1[2][2];
    const char* cA = (const char*)g.A + (size_t)cur.pm * tstepA; const char* cB = (const char*)g.Bt + (size_t)cur.pn * tstepB;
    PG8_STAGE(PG8_SB(0, 0), cB, voffB); PG8_STAGE(PG8_SB(0, 1), cB + hstepB, voffB); PG8_STAGE(PG8_SA(0, 0), cA, voffA); PG8_STAGE(PG8_SA(0, 1), cA + hstepA, voffA);
    if (wr == 1) PG8_BAR;
    PG8_WAIT_V(2); PG8_BAR;
    PG8_STAGE(PG8_SB(1, 0), cB + kstep, voffB); PG8_STAGE(PG8_SA(1, 0), cA + kstep, voffA); PG8_STAGE(PG8_SB(1, 1), cB + hstepB + kstep, voffB);
    PG8_WAIT_V(6); PG8_BAR;
    for (;;) {
        const bool has_next = S.next(ui + 1, nxt);
        const char* nA = has_next ? (const char*)g.A + (size_t)nxt.pm * tstepA : cA; const char* nB = has_next ? (const char*)g.Bt + (size_t)nxt.pn * tstepB : cB;
        for (int t = 0; t < nt; t += 2) {
            const bool last = (t == nt - 2);
            const char* a1 = cA + (size_t)(t + 1) * kstep;
            const char* a2 = last ? nA : cA + (size_t)(t + 2) * kstep; const char* b2 = last ? nB : cB + (size_t)(t + 2) * kstep;
            const char* a3 = a2 + kstep; const char* b3 = b2 + kstep;
            PG8_LDB(B0, 0, 0); PG8_LDB(B1, 0, 1); PG8_SCHED; PG8_LDA(At, 0, 0); PG8_STAGE(PG8_SA(1, 1), a1 + hstepA, voffA);
            PG8_WAIT_V(8); PG8_WAIT_L(0); PG8_BAR; PG8_MMA(0, 0, At, B0); PG8_MMA(0, 1, At, B1); PG8_BAR; PG8_SCHED;
            PG8_LDA(At, 0, 1); PG8_STAGE(PG8_SB(0, 0), b2, voffB); PG8_STAGE(PG8_SB(0, 1), b2 + hstepB, voffB); PG8_STAGE(PG8_SA(0, 0), a2, voffA);
            PG8_WAIT_V(8); PG8_WAIT_L(0); PG8_BAR; PG8_MMA(1, 0, At, B0); PG8_MMA(1, 1, At, B1); PG8_BAR; PG8_SCHED;
            PG8_LDB(B0, 1, 0); PG8_LDB(B1, 1, 1); PG8_SCHED; PG8_LDA(At, 1, 0); PG8_STAGE(PG8_SA(0, 1), a2 + hstepA, voffA);
            PG8_WAIT_V(8); PG8_WAIT_L(0); PG8_BAR; PG8_MMA(0, 0, At, B0); PG8_MMA(0, 1, At, B1); PG8_BAR; PG8_SCHED;
            PG8_LDA(At, 1, 1); PG8_STAGE(PG8_SB(1, 0), b3, voffB); PG8_STAGE(PG8_SB(1, 1), b3 + hstepB, voffB); PG8_STAGE(PG8_SA(1, 0), a3, voffA);
            PG8_WAIT_V(8); PG8_WAIT_L(0); PG8_BAR; PG8_MMA(1, 0, At, B0); PG8_MMA(1, 1, At, B1); PG8_BAR; PG8_SCHED;
        }
        if (wr == 0) PG8_BAR;
        E(acc, cur, wr, wc, fr, fq);
        if (!has_next) break;
#pragma unroll
        for (int a = 0; a < 2; ++a)
#pragma unroll
            for (int b = 0; b < 2; ++b)
#pragma unroll
                for (int m = 0; m < 4; ++m)
#pragma unroll
                    for (int n = 0; n < 2; ++n) acc[a][b][m][n] = (f32x4){0.f, 0.f, 0.f, 0.f};
        cur = nxt; cA = nA; cB = nB; ++ui;
        if (wr == 1) PG8_BAR;
    }
    PG8_WAIT_V(0);
    PG8_BAR;
#undef PG8_SA
#undef PG8_SB
#undef PG8_STAGE
#undef PG8_LDA
#undef PG8_LDB
#undef PG8_MMA
#undef PG8_WAIT_V
#undef PG8_WAIT_L
#undef PG8_BAR
#undef PG8_SCHED
}

struct EpiPlain {
    bf16_t* O; const float* rs; int ldc, rs_stride;
    __device__ __forceinline__ void operator()(const f32x4 (&acc)[2][2][4][2], const Unit& u, int wr, int wc, int fr, int fq) const {
#pragma unroll
        for (int ai = 0; ai < 2; ++ai)
#pragma unroll
            for (int m = 0; m < 4; ++m) {
                const int row = u.pm * BM + ai * HALF + wr * 64 + m * 16 + fr;
                const float sc = rs ? rs[(size_t)row * rs_stride] : 1.f;
                bf16_t* rowp = O + (size_t)row * ldc + u.pn * BM + wc * 32 + 4 * fq;
#pragma unroll
                for (int bj = 0; bj < 2; ++bj)
#pragma unroll
                    for (int n = 0; n < 2; ++n) { const f32x4 v = acc[ai][bj][m][n] * sc; u32x2 w; w.x = pk2(v[0], v[1]); w.y = pk2(v[2], v[3]);
                        *(u32x2*)(rowp + bj * HALF + n * 16) = w; }
            }
    }
};
struct EpiResid {
    float* H; const float* modl;
    __device__ __forceinline__ void operator()(const f32x4 (&acc)[2][2][4][2], const Unit& u, int wr, int wc, int fr, int fq) const {
        const int b = u.pm / 9, cond = (u.pm % 9 == 0) ? 4 : b;
        const float* gt = modl + cond * 6144 + 4096;
        const int col0 = u.pn * BM + wc * 32 + 4 * fq;
#pragma unroll
        for (int bj = 0; bj < 2; ++bj)
#pragma unroll
            for (int n = 0; n < 2; ++n) { const f32x4 g4 = *(const f32x4*)(gt + col0 + bj * HALF + n * 16);
#pragma unroll
                for (int ai = 0; ai < 2; ++ai)
#pragma unroll
                    for (int m = 0; m < 4; ++m) { const int row = u.pm * BM + ai * HALF + wr * 64 + m * 16 + fr;
                        float* p = H + (size_t)row * DM + col0 + bj * HALF + n * 16; const f32x4 h = *(const f32x4*)p;
                        *(f32x4*)p = h * ALPHA + g4 * acc[ai][bj][m][n]; } }
    }
};

struct EpiIn {
    bf16_t* U; float* ssqp; const f32x2* cs;
    __device__ __forceinline__ void operator()(const f32x4 (&acc)[2][2][4][2], const Unit& u, int wr, int wc, int fr, int fq) const {
#pragma unroll
        for (int ai = 0; ai < 2; ++ai)
#pragma unroll
            for (int m = 0; m < 4; ++m) {
                const int row = u.pm * BM + ai * HALF + wr * 64 + m * 16 + fr;
                bf16_t* rowp = U + (size_t)row * NU;
                float ss = 0.f;
#pragma unroll
                for (int bj = 0; bj < 2; ++bj) {
                    const int c0 = u.pn * BM + bj * HALF + wc * 32 + 4 * fq;
                    f32x4 v0 = acc[ai][bj][m][0], v1 = acc[ai][bj][m][1];
                    ss += (v0[0] * v0[0] + v0[1] * v0[1]) + (v0[2] * v0[2] + v0[3] * v0[3]) + (v1[0] * v1[0] + v1[1] * v1[1]) + (v1[2] * v1[2] + v1[3] * v1[3]);
                    in_transform(row, c0, v0, v1, cs);
                    st4bf(rowp + c0, v0); st4bf(rowp + c0 + 16, v1);
                }
                if (u.pn < 3) { ss += __shfl_xor(ss, 16); ss += __shfl_xor(ss, 32); if (fq == 0) ssqp[(size_t)row * 12 + u.pn * 4 + wc] = ss; }
            }
    }
};
template <int MODE> struct EpiUp {
    bf16_t* O; const float* ssqp; const f32x2* cs;
    __device__ __forceinline__ void operator()(const f32x4 (&acc)[2][2][4][2], const Unit& u, int wr, int wc, int fr, int fq) const {
        constexpr int LDC = MODE == 0 ? NQ : NKV;
#pragma unroll
        for (int ai = 0; ai < 2; ++ai)
#pragma unroll
            for (int m = 0; m < 4; ++m) {
                const int row = u.pm * BM + ai * HALF + wr * 64 + m * 16 + fr;
                const float* sp = ssqp + (size_t)row * 12; float rs;
                if (MODE == 0) { const f32x4 a = *(const f32x4*)sp, b = *(const f32x4*)(sp + 4); rs = 1.f / sqrtf(((a[0] + a[1]) + (a[2] + a[3]) + (b[0] + b[1]) + (b[2] + b[3])) * (1.f / 512) + RMS_EPS); }
                else { const f32x4 a = *(const f32x4*)(sp + 8); rs = 1.f / sqrtf(((a[0] + a[1]) + (a[2] + a[3])) * (1.f / 256) + RMS_EPS); }
                const int s = row % SROW; const bool lat = s >= CTXL; const int t = s - CTXL;
                bf16_t* rowp = O + (size_t)row * LDC;
#pragma unroll
                for (int bj = 0; bj < 2; ++bj) {
                    const int c0 = u.pn * BM + bj * HALF + wc * 32 + 4 * fq;
                    f32x4 v0 = acc[ai][bj][m][0] * rs, v1 = acc[ai][bj][m][1] * rs;
                    if (MODE == 0) { const int e0 = (c0 % 192) - 128;
                        if (e0 >= 0 && lat) { const int a = e0 >> 5, i0 = e0 & 15, pos = a ? (t & 63) : (t >> 6);
#pragma unroll
                            for (int j = 0; j < 4; ++j) { const f32x2 c = cs[pos * 32 + 2 * (i0 + j)]; const float x1 = v0[j], x2 = v1[j]; v0[j] = x1 * c[0] - x2 * c[1]; v1[j] = x2 * c[0] + x1 * c[1]; } } }
                    st4bf(rowp + c0, v0); st4bf(rowp + c0 + 16, v1);
                }
            }
    }
};
}


namespace mla {
using f32x16 = __attribute__((ext_vector_type(16))) float;
using s16x4  = __attribute__((ext_vector_type(4))) short;
constexpr int QBLK = 32, KVBLK = 64;
constexpr int SHM_V = KVBLK * 128 * 2, SHM_KN = KVBLK * 128 * 2, SHM_KR = KVBLK * 64 * 2;
constexpr int OFF_V = 0, OFF_KN = 2 * SHM_V, OFF_KR = OFF_KN + 2 * SHM_KN, OFF_WS = OFF_KR + 2 * SHM_KR, OFF_QR = OFF_WS + 8 * 64 * 4, LDS_BYTES = OFF_QR + 8 * 4096;
constexpr float THR = 8.f;
#define KSWZ(row, colB) ((row) * 256 + ((colB) ^ (((row) & 7) << 4)))
#define KRSWZ(row, colB) ((row) * 128 + ((colB) ^ (((row) & 7) << 4)))
#define SBAR() __builtin_amdgcn_sched_barrier(0)
__device__ __forceinline__ int crow(int r, int hi) { return (r & 3) + 8 * (r >> 2) + 4 * hi; }
__device__ __forceinline__ unsigned cvtpk(float lo, float hi) { unsigned r; asm volatile("v_cvt_pk_bf16_f32 %0, %1, %2" : "=v"(r) : "v"(lo), "v"(hi)); return r; }

__device__ __forceinline__ void partialSM(f32x16& p0, f32x16& p1, float& m_reg, float& mn, float& alpha) {
  constexpr float C = MLA_SCALE * 1.4426950408889634f;
  float pmax = p0[0];
#pragma unroll
  for (int r = 1; r < 16; ++r) pmax = fmaxf(pmax, p0[r]);
#pragma unroll
  for (int r = 0; r < 16; ++r) pmax = fmaxf(pmax, p1[r]);
  { auto rr = __builtin_amdgcn_permlane32_swap(__float_as_uint(pmax), __float_as_uint(pmax), false, false);
    pmax = fmaxf(__uint_as_float(rr[0]), __uint_as_float(rr[1])); }
  if (__builtin_expect(__all(pmax - m_reg <= THR / MLA_SCALE), 1)) { mn = m_reg; alpha = 1.f; }
  else { mn = fmaxf(m_reg, pmax); alpha = __builtin_amdgcn_exp2f((m_reg - mn) * C); m_reg = mn; }
  float mnC = -mn * C;
#pragma unroll
  for (int r = 0; r < 16; ++r) p0[r] = fmaf(p0[r], C, mnC);
#pragma unroll
  for (int r = 0; r < 16; ++r) p1[r] = fmaf(p1[r], C, mnC);
#pragma unroll
  for (int r = 0; r < 16; ++r) p0[r] = __builtin_amdgcn_exp2f(p0[r]);
}
#define PK4(P, BASE, OUT) do { unsigned a0 = cvtpk(P[BASE + 0], P[BASE + 1]), a1 = cvtpk(P[BASE + 2], P[BASE + 3]);   \
    unsigned b0 = cvtpk(P[BASE + 4], P[BASE + 5]), b1 = cvtpk(P[BASE + 6], P[BASE + 7]);                              \
    auto r0 = __builtin_amdgcn_permlane32_swap(a0, b0, false, false); auto r1 = __builtin_amdgcn_permlane32_swap(a1, b1, false, false); \
    u32x4 w = {r0[0], r1[0], r0[1], r1[1]}; OUT = *reinterpret_cast<bf16x8*>(&w); } while (0)
__device__ __forceinline__ void finishSM(f32x16& p0, f32x16& p1, float alpha, float& l_reg, bf16x8& pa0, bf16x8& pa1, bf16x8& pa2, bf16x8& pa3) {
#pragma unroll
  for (int r = 0; r < 16; ++r) p1[r] = __builtin_amdgcn_exp2f(p1[r]);
  float ps = 0;
#pragma unroll
  for (int r = 0; r < 16; ++r) ps += p0[r];
#pragma unroll
  for (int r = 0; r < 16; ++r) ps += p1[r];
  { auto rr = __builtin_amdgcn_permlane32_swap(__float_as_uint(ps), __float_as_uint(ps), false, false);
    ps = __uint_as_float(rr[0]) + __uint_as_float(rr[1]); }
  l_reg = l_reg * alpha + ps;
  PK4(p0, 0, pa0); PK4(p0, 8, pa1); PK4(p1, 0, pa2); PK4(p1, 8, pa3);
}
__device__ __forceinline__ void qkt(f32x16& p0, f32x16& p1, const char* Kn, const char* Kr, const bf16x8* qr, const char* Qr, int r32, int hi) {
  p0 = f32x16{}; p1 = f32x16{};
  const int sw = r32 & 7; const int kn0 = r32 * 256, kr0 = r32 * 128;
#pragma unroll
  for (int d0 = 0; d0 < 8; ++d0) { const int off = kn0 + (d0 >> 2) * 128 + ((((d0 & 3) * 2 + hi) ^ sw) << 4);
    const bf16x8 b0 = *reinterpret_cast<const bf16x8*>(Kn + off);
    const bf16x8 b1 = *reinterpret_cast<const bf16x8*>(Kn + off + 32 * 256);
    p0 = __builtin_amdgcn_mfma_f32_32x32x16_bf16(b0, qr[d0], p0, 0, 0, 0);
    p1 = __builtin_amdgcn_mfma_f32_32x32x16_bf16(b1, qr[d0], p1, 0, 0, 0); }
#pragma unroll
  for (int d0 = 0; d0 < 4; ++d0) { const int off = kr0 + (((d0 * 2 + hi) ^ sw) << 4);
    const bf16x8 b0 = *reinterpret_cast<const bf16x8*>(Kr + off);
    const bf16x8 b1 = *reinterpret_cast<const bf16x8*>(Kr + off + 32 * 128);
    const bf16x8 qf = *reinterpret_cast<const bf16x8*>(Qr + off);
    p0 = __builtin_amdgcn_mfma_f32_32x32x16_bf16(b0, qf, p0, 0, 0, 0);
    p1 = __builtin_amdgcn_mfma_f32_32x32x16_bf16(b1, qf, p1, 0, 0, 0); }
}
__device__ __forceinline__ int v_st(int k, int c) { const int kk = (k & ~0xC) | ((k & 4) << 1) | ((k & 8) >> 1); return ((kk >> 3) * 4 + (c >> 5)) * 512 + ((kk & 7) * 32 + (c & 31)) * 2; }
__device__ __forceinline__ int v_rd_base(int lane) { return ((lane & 3) << 3) | (((lane >> 2) & 3) << 6) | (((lane >> 4) & 1) << 5) | (((lane >> 5) & 1) << 8); }
constexpr int v_rd_off(int d0, int ks, int half) { return d0 * 512 + ks * 4096 + half * 2048; }
template <int OFF> __device__ __forceinline__ s16x4 tr_read(int vb) {
  s16x4 r; asm volatile("ds_read_b64_tr_b16 %0, %1 offset:%2" : "=&v"(r) : "v"(vb), "i"(OFF) : "memory"); return r;
}
template <int D0> __device__ __forceinline__ void pv_one(f32x16& od, int vb, bf16x8 pa0, bf16x8 pa1, bf16x8 pa2, bf16x8 pa3) {
#define PK(L, H) (bf16x8){L[0], L[1], L[2], L[3], H[0], H[1], H[2], H[3]}
  { const s16x4 l0 = tr_read<v_rd_off(D0, 0, 0)>(vb), h0 = tr_read<v_rd_off(D0, 0, 1)>(vb), l1 = tr_read<v_rd_off(D0, 1, 0)>(vb), h1 = tr_read<v_rd_off(D0, 1, 1)>(vb);
    asm volatile("s_waitcnt lgkmcnt(0)" ::: "memory"); SBAR();
    od = __builtin_amdgcn_mfma_f32_32x32x16_bf16(pa0, PK(l0, h0), od, 0, 0, 0);
    od = __builtin_amdgcn_mfma_f32_32x32x16_bf16(pa1, PK(l1, h1), od, 0, 0, 0); }
  SBAR();
  { const s16x4 l2 = tr_read<v_rd_off(D0, 2, 0)>(vb), h2 = tr_read<v_rd_off(D0, 2, 1)>(vb), l3 = tr_read<v_rd_off(D0, 3, 0)>(vb), h3 = tr_read<v_rd_off(D0, 3, 1)>(vb);
    asm volatile("s_waitcnt lgkmcnt(0)" ::: "memory"); SBAR();
    od = __builtin_amdgcn_mfma_f32_32x32x16_bf16(pa2, PK(l2, h2), od, 0, 0, 0);
    od = __builtin_amdgcn_mfma_f32_32x32x16_bf16(pa3, PK(l3, h3), od, 0, 0, 0); }
#undef PK
}
__device__ __forceinline__ void pv_d0(f32x16* o, int vb, bf16x8 pa0, bf16x8 pa1, bf16x8 pa2, bf16x8 pa3) {
  pv_one<0>(o[0], vb, pa0, pa1, pa2, pa3); pv_one<1>(o[1], vb, pa0, pa1, pa2, pa3); pv_one<2>(o[2], vb, pa0, pa1, pa2, pa3); pv_one<3>(o[3], vb, pa0, pa1, pa2, pa3);
}

__device__ __forceinline__ void attn_unit(const bf16_t* __restrict__ Qb, const bf16_t* __restrict__ Kn, const bf16_t* __restrict__ Vh, const bf16_t* __restrict__ Krp,
                                          const bf16_t* __restrict__ Gb, bf16_t* __restrict__ Yb, int seq, char* lds) {
  const int tid = threadIdx.x, wid = __builtin_amdgcn_readfirstlane(tid >> 6), lane = tid & 63, r32 = lane & 31, hi = lane >> 5;
  char* V_lds = lds + OFF_V; char* KN_lds = lds + OFF_KN; char* KR_lds = lds + OFF_KR;
  float* ws = (float*)(lds + OFF_WS) + wid * 64; float* li_l = ws; float* al_l = ws + 32;
  float m_reg = -1e30f, l_reg = 0; f32x16 o[4] = {}; bf16x8 qr[8];
  const bf16_t* Qw = Qb + (long)(wid * QBLK + r32) * NQ + hi * 8;
  char* QR_lds = lds + OFF_QR + wid * 4096;
#pragma unroll
  for (int d0 = 0; d0 < 8; ++d0) qr[d0] = *reinterpret_cast<const bf16x8*>(Qw + d0 * 16);
#pragma unroll
  for (int d0 = 0; d0 < 4; ++d0) *(bf16x8*)(QR_lds + KRSWZ(r32, (d0 * 16 + hi * 8) * 2)) = *reinterpret_cast<const bf16x8*>(Qw + 128 + d0 * 16);
  const int sr = tid >> 4, sc = (tid & 15) * 8, vst0 = v_st(sr, sc), vst1 = v_st(32 + sr, sc);
  const int krr = tid >> 3, krc = (tid & 7) * 8;
  const int vb0 = (int)(uintptr_t)V_lds + v_rd_base(lane);
  bf16x8 vs0, vs1, ks0, ks1, kr0;
#define SLOAD(k0) do { vs0 = *reinterpret_cast<const bf16x8*>(&Vh[(long)((k0) + sr) * NKV + sc]); vs1 = *reinterpret_cast<const bf16x8*>(&Vh[(long)((k0) + 32 + sr) * NKV + sc]); \
    ks0 = *reinterpret_cast<const bf16x8*>(&Kn[(long)((k0) + sr) * NKV + sc]); ks1 = *reinterpret_cast<const bf16x8*>(&Kn[(long)((k0) + 32 + sr) * NKV + sc]); \
    kr0 = *reinterpret_cast<const bf16x8*>(&Krp[(long)((k0) + krr) * NU + krc]); } while (0)
#define SWRITE(b) do { *(bf16x8*)(V_lds + (b) * SHM_V + vst0) = vs0; *(bf16x8*)(V_lds + (b) * SHM_V + vst1) = vs1; const int kc = sc * 2; \
    *(bf16x8*)(KN_lds + (b) * SHM_KN + KSWZ(sr, kc)) = ks0; *(bf16x8*)(KN_lds + (b) * SHM_KN + KSWZ(32 + sr, kc)) = ks1; \
    *(bf16x8*)(KR_lds + (b) * SHM_KR + KRSWZ(krr, krc * 2)) = kr0; } while (0)
#define SWAIT() asm volatile("s_waitcnt vmcnt(0)" ::: "memory")
#define RESC(a) do { if (__any((a) < 1.f)) { if (hi == 0) al_l[r32] = (a); asm volatile("s_waitcnt lgkmcnt(0)" ::: "memory"); \
    _Pragma("unroll") for (int d = 0; d < 4; ++d) _Pragma("unroll") for (int r = 0; r < 16; ++r) o[d][r] *= al_l[crow(r, hi)]; } } while (0)
  f32x16 pA0, pA1, pB0, pB1; float mnA, mnB, alA, alB; bf16x8 pa0, pa1, pa2, pa3; const int NT = seq / KVBLK;
  SLOAD(0); SWAIT(); SWRITE(0); __syncthreads();
  qkt(pA0, pA1, KN_lds, KR_lds, qr, QR_lds, r32, hi); partialSM(pA0, pA1, m_reg, mnA, alA);
  SLOAD(KVBLK);
  SWAIT(); SWRITE(1); __syncthreads();
  for (int j = 1; j + 1 < NT; j += 2) {
    SBAR(); qkt(pB0, pB1, KN_lds + SHM_KN, KR_lds + SHM_KR, qr, QR_lds, r32, hi);
    finishSM(pA0, pA1, alA, l_reg, pa0, pa1, pa2, pa3); SBAR();
    SLOAD((j + 1) * KVBLK); SBAR();
    pv_d0(o, vb0, pa0, pa1, pa2, pa3); partialSM(pB0, pB1, m_reg, mnB, alB);
    __syncthreads(); SWAIT(); SWRITE(0);
    RESC(alB); __syncthreads();
    SBAR(); qkt(pA0, pA1, KN_lds, KR_lds, qr, QR_lds, r32, hi);
    finishSM(pB0, pB1, alB, l_reg, pa0, pa1, pa2, pa3); SBAR();
    SLOAD((j + 2) * KVBLK); SBAR();
    pv_d0(o, vb0 + SHM_V, pa0, pa1, pa2, pa3); partialSM(pA0, pA1, m_reg, mnA, alA);
    __syncthreads(); SWAIT(); SWRITE(1);
    RESC(alA); __syncthreads();
  }
  SBAR(); qkt(pB0, pB1, KN_lds + SHM_KN, KR_lds + SHM_KR, qr, QR_lds, r32, hi);
  finishSM(pA0, pA1, alA, l_reg, pa0, pa1, pa2, pa3); SBAR();
  pv_d0(o, vb0, pa0, pa1, pa2, pa3); partialSM(pB0, pB1, m_reg, mnB, alB);
  __syncthreads(); RESC(alB);
  finishSM(pB0, pB1, alB, l_reg, pa0, pa1, pa2, pa3); SBAR();
  pv_d0(o, vb0 + SHM_V, pa0, pa1, pa2, pa3);
  if (hi == 0) li_l[r32] = l_reg; asm volatile("s_waitcnt lgkmcnt(0)" ::: "memory");
  float rli[16];
#pragma unroll
  for (int r = 0; r < 16; ++r) rli[r] = __builtin_amdgcn_rcpf(li_l[crow(r, hi)]);
  __syncthreads();
  { bf16_t* stg = (bf16_t*)(lds + wid * 8192);
#pragma unroll
    for (int r = 0; r < 16; ++r) { const int orow = crow(r, hi);
#pragma unroll
      for (int d0 = 0; d0 < 4; ++d0) stg[orow * 128 + d0 * 32 + r32] = (bf16_t)f2bf(o[d0][r] * rli[r]); }
    asm volatile("s_waitcnt lgkmcnt(0)" ::: "memory");
    int ln = lane; asm volatile("" : "+v"(ln));
    const bf16_t* Gw = Gb + (long)(wid * QBLK + (ln >> 4)) * NU + (ln & 15) * 8; bf16_t* Yw = Yb + (long)(wid * QBLK + (ln >> 4)) * DM + (ln & 15) * 8;
    const bf16_t* sp = stg + (ln >> 4) * 128 + (ln & 15) * 8;
#pragma unroll
    for (int i = 0; i < 8; ++i) { const u32x4 ov = *(const u32x4*)(sp + i * 4 * 128); const u32x4 gv = *(const u32x4*)(Gw + (long)i * 4 * NU); u32x4 w;
#pragma unroll
      for (int j = 0; j < 4; ++j) { const float a0 = __uint_as_float(ov[j] << 16) * __uint_as_float(gv[j] << 16), a1 = __uint_as_float(ov[j] & 0xffff0000u) * __uint_as_float(gv[j] & 0xffff0000u); w[j] = pk2(a0, a1); }
      *(u32x4*)(Yw + (long)i * 4 * DM) = w; } }
  __syncthreads();
#undef SLOAD
#undef SWRITE
#undef SWAIT
#undef RESC
}
#undef PK4
#undef KSWZ
#undef KRSWZ
#undef SBAR

__device__ __forceinline__ void attn_phase(const Params& p, int do_ctx, char* lds) {
  const bf16_t* U = (const bf16_t*)(p.ws + WS_U); const bf16_t* Q = (const bf16_t*)(p.ws + WS_Q); const bf16_t* KV = (const bf16_t*)(p.ws + WS_KV); bf16_t* Y = (bf16_t*)(p.ws + WS_Y);
  const int G = gridDim.x, bx = blockIdx.x; const int vcu = (G % 8 == 0) ? (bx % 8) * (G / 8) + bx / 8 : bx;
  for (int it = vcu; it < 256 + 256; it += G) {
    int bh, qrel, seq;
    if (it < 256) { bh = it >> 3; qrel = CTXL + (it & 7) * 256; seq = SROW; }
    else { const int cu = it - 256; if (!do_ctx || (cu & 7)) continue; bh = cu >> 3; qrel = 0; seq = CTXL; }
    const int b = bh >> 3, h = bh & 7; const long krow0 = (long)b * SROW, qrow0 = krow0 + qrel;
    attn_unit(Q + qrow0 * NQ + h * 192, KV + krow0 * NKV + h * 256, KV + krow0 * NKV + h * 256 + 128, U + krow0 * NU + U_KR, U + qrow0 * NU + U_GMLA + h * 128, Y + qrow0 * DM + h * 128, seq, lds);
  }
}
}
__global__ void __launch_bounds__(512, 2) attn_kernel(Params p, int do_ctx) {
    extern __shared__ __attribute__((aligned(16))) unsigned char lds[];
    mla::attn_phase(p, do_ctx, (char*)lds);
}

namespace ret {
using mla::f32x16; using mla::s16x4; using mla::crow; using mla::cvtpk; using mla::v_st; using mla::v_rd_base; using mla::v_rd_off; using mla::tr_read;
#define KSWZ(row, colB) ((row) * 256 + ((colB) ^ (((row) & 7) << 4)))
#define SBAR() __builtin_amdgcn_sched_barrier(0)
#define PK(L, H) (bf16x8){L[0], L[1], L[2], L[3], H[0], H[1], H[2], H[3]}
__device__ __forceinline__ size_t st_off(int b, int h, int i, int dir) { return (((size_t)(b * 4 + h) * 18 + i) * 2 + dir) * 16384; }
__device__ __forceinline__ float log_sig(float x) { return -log1pf(expf(-x)); }
__device__ __forceinline__ u32x4 scale8(u32x4 v, float z) { u32x4 w;
#pragma unroll
    for (int j = 0; j < 4; ++j) w[j] = pk2(__uint_as_float(v[j] << 16) * z, __uint_as_float(v[j] & 0xffff0000u) * z);
    return w; }
template <int D0, int KS> __device__ __forceinline__ bf16x8 tr_frag(int vb) {
    const s16x4 l = tr_read<(KS >> 2) * 16384 + v_rd_off(D0, KS & 3, 0)>(vb), h = tr_read<(KS >> 2) * 16384 + v_rd_off(D0, KS & 3, 1)>(vb);
    asm volatile("s_waitcnt lgkmcnt(0)" ::: "memory"); SBAR();
    return PK(l, h);
}
constexpr int P_OFF_V = 0, P_OFF_KF = 32768, P_OFF_KB = 65536, PREP_LDS = 98304;
template <int KS> __device__ __forceinline__ void prep_kstep(f32x16 (&acc)[4], int vbA, int vbB) {
    const bf16x8 a = tr_frag<0, KS>(vbA);
    { const bf16x8 b0 = tr_frag<0, KS>(vbB); acc[0] = __builtin_amdgcn_mfma_f32_32x32x16_bf16(a, b0, acc[0], 0, 0, 0); }
    { const bf16x8 b1 = tr_frag<1, KS>(vbB); acc[1] = __builtin_amdgcn_mfma_f32_32x32x16_bf16(a, b1, acc[1], 0, 0, 0); }
    { const bf16x8 b2 = tr_frag<2, KS>(vbB); acc[2] = __builtin_amdgcn_mfma_f32_32x32x16_bf16(a, b2, acc[2], 0, 0, 0); }
    { const bf16x8 b3 = tr_frag<3, KS>(vbB); acc[3] = __builtin_amdgcn_mfma_f32_32x32x16_bf16(a, b3, acc[3], 0, 0, 0); }
}
__device__ __forceinline__ void prep_unit(const Params& p, int layer, int b, int h, int i, char* lds) {
    const int tid = threadIdx.x, wid = __builtin_amdgcn_readfirstlane(tid >> 6), lane = tid & 63, r32 = lane & 31, hi = lane >> 5;
    const bf16_t* U = (const bf16_t*)(p.ws + WS_U); float* ST = (float*)(p.ws + WS_RST);
    const float lgf = log_sig(p.ret_decay[(layer * 2 + 0) * 4 + h]), lgb = log_sig(p.ret_decay[(layer * 2 + 1) * 4 + h]);
    const long row0 = (long)b * SROW + i * 128;
    { const int tok = tid >> 2, cpart = (tid & 3) * 32; const float zf = expf(lgf * (float)(127 - tok)), zb = expf(lgb * (float)tok);
      const bf16_t* ur = U + (row0 + tok) * NU + h * 128 + cpart; const int img = (tok >> 6) * 16384;
#pragma unroll
      for (int c4 = 0; c4 < 4; ++c4) { const u32x4 v = *(const u32x4*)(ur + U_RV + c4 * 8), k = *(const u32x4*)(ur + U_RK + c4 * 8); const int o = img + v_st(tok & 63, cpart + c4 * 8);
          *(u32x4*)(lds + P_OFF_V + o) = v; *(u32x4*)(lds + P_OFF_KF + o) = scale8(k, zf); *(u32x4*)(lds + P_OFF_KB + o) = scale8(k, zb); } }
    __syncthreads();
    const int dir = wid >> 2, mb = wid & 3;
    const int vbA = (int)(uintptr_t)(lds + P_OFF_V) + v_rd_base(lane) + mb * 512, vbB = (int)(uintptr_t)(lds + (dir ? P_OFF_KB : P_OFF_KF)) + v_rd_base(lane);
    f32x16 acc[4] = {};
    prep_kstep<0>(acc, vbA, vbB); prep_kstep<1>(acc, vbA, vbB); prep_kstep<2>(acc, vbA, vbB); prep_kstep<3>(acc, vbA, vbB);
    prep_kstep<4>(acc, vbA, vbB); prep_kstep<5>(acc, vbA, vbB); prep_kstep<6>(acc, vbA, vbB); prep_kstep<7>(acc, vbA, vbB);
    float* o = ST + st_off(b, h, i, dir) + (size_t)(32 * mb) * 128 + r32;
#pragma unroll
    for (int r = 0; r < 16; ++r) { const int dv = crow(r, hi);
#pragma unroll
        for (int nb = 0; nb < 4; ++nb) o[dv * 128 + nb * 32] = acc[nb][r]; }
    __syncthreads();
}
__device__ __forceinline__ void prep_phase(const Params& p, int layer, char* lds) {
    for (int unit = blockIdx.x; unit < NBATCH * 4 * 18; unit += gridDim.x) { const int bh = unit / 18, i = unit % 18; prep_unit(p, layer, bh >> 2, bh & 3, i, lds); }
}

constexpr int O_OFF_K = 0, O_OFF_V = 32768, O_OFF_RT = 65536, O_OFF_SB = 98304, O_OFF_STAT = 131072, OUT_LDS = 131072 + 2048;
__device__ __forceinline__ int bwd_pos(int i) { return i < 2 ? 16 + i : i - 2; }
template <int D0> __device__ __forceinline__ void pv_blk(f32x16& od, int vb, bf16x8 pa0, bf16x8 pa1, bf16x8 pa2, bf16x8 pa3) {
    { const s16x4 l0 = tr_read<v_rd_off(D0, 0, 0)>(vb), h0 = tr_read<v_rd_off(D0, 0, 1)>(vb), l1 = tr_read<v_rd_off(D0, 1, 0)>(vb), h1 = tr_read<v_rd_off(D0, 1, 1)>(vb);
      asm volatile("s_waitcnt lgkmcnt(0)" ::: "memory"); SBAR();
      od = __builtin_amdgcn_mfma_f32_32x32x16_bf16(pa0, PK(l0, h0), od, 0, 0, 0); od = __builtin_amdgcn_mfma_f32_32x32x16_bf16(pa1, PK(l1, h1), od, 0, 0, 0); }
    SBAR();
    { const s16x4 l2 = tr_read<v_rd_off(D0, 2, 0)>(vb), h2 = tr_read<v_rd_off(D0, 2, 1)>(vb), l3 = tr_read<v_rd_off(D0, 3, 0)>(vb), h3 = tr_read<v_rd_off(D0, 3, 1)>(vb);
      asm volatile("s_waitcnt lgkmcnt(0)" ::: "memory"); SBAR();
      od = __builtin_amdgcn_mfma_f32_32x32x16_bf16(pa2, PK(l2, h2), od, 0, 0, 0); od = __builtin_amdgcn_mfma_f32_32x32x16_bf16(pa3, PK(l3, h3), od, 0, 0, 0); }
}
#define PK4(P, BASE, OUT) do { unsigned a0 = cvtpk(P[BASE + 0], P[BASE + 1]), a1 = cvtpk(P[BASE + 2], P[BASE + 3]);   \
    unsigned b0 = cvtpk(P[BASE + 4], P[BASE + 5]), b1 = cvtpk(P[BASE + 6], P[BASE + 7]);                              \
    auto r0 = __builtin_amdgcn_permlane32_swap(a0, b0, false, false); auto r1 = __builtin_amdgcn_permlane32_swap(a1, b1, false, false); \
    u32x4 w = {r0[0], r1[0], r0[1], r1[1]}; OUT = *reinterpret_cast<bf16x8*>(&w); } while (0)
__device__ __forceinline__ void out_unit(const Params& p, int layer, int b, int h, int i, char* lds) {
    const int tid = threadIdx.x, wid = __builtin_amdgcn_readfirstlane(tid >> 6), lane = tid & 63, r32 = lane & 31, hi = lane >> 5;
    const bf16_t* U = (const bf16_t*)(p.ws + WS_U); const float* ST = (const float*)(p.ws + WS_RST); bf16_t* Y = (bf16_t*)(p.ws + WS_Y);
    const float lgf = log_sig(p.ret_decay[(layer * 2 + 0) * 4 + h]), lgb = log_sig(p.ret_decay[(layer * 2 + 1) * 4 + h]);
    const long row0 = (long)b * SROW + i * 128;
    { f32x4 aR[4][2], aS[4][2];
#pragma unroll
      for (int j = 0; j < 4; ++j) { aR[j][0] = aR[j][1] = aS[j][0] = aS[j][1] = (f32x4){0.f, 0.f, 0.f, 0.f}; }
      for (int ip = 0; ip < i; ++ip) { const float w = expf(lgf * 128.f * (float)(i - 1 - ip)); const float* s = ST + st_off(b, h, ip, 0) + tid * 8;
#pragma unroll
          for (int j = 0; j < 4; ++j) { aR[j][0] += *(const f32x4*)(s + j * 4096) * w; aR[j][1] += *(const f32x4*)(s + j * 4096 + 4) * w; } }
      const int pi = bwd_pos(i);
      for (int ip = 0; ip < 18; ++ip) { const int pp = bwd_pos(ip); if (pp <= pi) continue; const float w = expf(lgb * 128.f * (float)(pp - pi - 1)); const float* s = ST + st_off(b, h, ip, 1) + tid * 8;
#pragma unroll
          for (int j = 0; j < 4; ++j) { aS[j][0] += *(const f32x4*)(s + j * 4096) * w; aS[j][1] += *(const f32x4*)(s + j * 4096 + 4) * w; } }
#pragma unroll
      for (int j = 0; j < 4; ++j) { const int e = tid * 8 + j * 4096, dv = e >> 7, dk = e & 127; const int o = KSWZ(dv, dk * 2);
          u32x4 w; w[0] = pk2(aR[j][0][0], aR[j][0][1]); w[1] = pk2(aR[j][0][2], aR[j][0][3]); w[2] = pk2(aR[j][1][0], aR[j][1][1]); w[3] = pk2(aR[j][1][2], aR[j][1][3]); *(u32x4*)(lds + O_OFF_RT + o) = w;
          w[0] = pk2(aS[j][0][0], aS[j][0][1]); w[1] = pk2(aS[j][0][2], aS[j][0][3]); w[2] = pk2(aS[j][1][0], aS[j][1][1]); w[3] = pk2(aS[j][1][2], aS[j][1][3]); *(u32x4*)(lds + O_OFF_SB + o) = w; } }
    { const int tok = tid >> 2, cpart = (tid & 3) * 32; const bf16_t* ur = U + (row0 + tok) * NU + h * 128 + cpart; const int img = (tok >> 6) * 16384;
#pragma unroll
      for (int c4 = 0; c4 < 4; ++c4) { const u32x4 v = *(const u32x4*)(ur + U_RV + c4 * 8), k = *(const u32x4*)(ur + U_RK + c4 * 8);
          *(u32x4*)(lds + O_OFF_V + img + v_st(tok & 63, cpart + c4 * 8)) = v; *(u32x4*)(lds + O_OFF_K + KSWZ(tok, (cpart + c4 * 8) * 2)) = k; } }
    const int qb = wid & 3, dvh = wid >> 2; bf16x8 qr[8];
    { const bf16_t* qw = U + (row0 + qb * 32 + r32) * NU + U_RQ + h * 128 + hi * 8;
#pragma unroll
      for (int d0 = 0; d0 < 8; ++d0) qr[d0] = *reinterpret_cast<const bf16x8*>(qw + d0 * 16); }
    __syncthreads();
    f32x16 o[2] = {};
    const float l2f = lgf * 1.4426950408889634f, l2b = lgb * 1.4426950408889634f; const int jq = qb * 32 + r32;
    const int sw = r32 & 7;
#pragma unroll
    for (int t = 0; t < 2; ++t) {
        f32x16 p0 = {}, p1 = {};
#pragma unroll
        for (int d0 = 0; d0 < 8; ++d0) { const int off = (t * 64 + r32) * 256 + (d0 >> 2) * 128 + ((((d0 & 3) * 2 + hi) ^ sw) << 4);
            const bf16x8 b0 = *reinterpret_cast<const bf16x8*>(lds + O_OFF_K + off), b1 = *reinterpret_cast<const bf16x8*>(lds + O_OFF_K + off + 32 * 256);
            p0 = __builtin_amdgcn_mfma_f32_32x32x16_bf16(b0, qr[d0], p0, 0, 0, 0); p1 = __builtin_amdgcn_mfma_f32_32x32x16_bf16(b1, qr[d0], p1, 0, 0, 0); }
#pragma unroll
        for (int r = 0; r < 16; ++r) { const int k0 = t * 64 + crow(r, hi), k1 = k0 + 32; const int d0 = jq - k0, d1 = jq - k1;
            p0[r] *= d0 >= 0 ? __builtin_amdgcn_exp2f(l2f * (float)d0) : __builtin_amdgcn_exp2f(l2b * (float)(-d0));
            p1[r] *= d1 >= 0 ? __builtin_amdgcn_exp2f(l2f * (float)d1) : __builtin_amdgcn_exp2f(l2b * (float)(-d1)); }
        bf16x8 pa0, pa1, pa2, pa3; PK4(p0, 0, pa0); PK4(p0, 8, pa1); PK4(p1, 0, pa2); PK4(p1, 8, pa3);
        const int vb = (int)(uintptr_t)(lds + O_OFF_V) + t * 16384 + v_rd_base(lane) + dvh * 1024;
        pv_blk<0>(o[0], vb, pa0, pa1, pa2, pa3); pv_blk<1>(o[1], vb, pa0, pa1, pa2, pa3);
    }
#pragma unroll
    for (int sd = 0; sd < 2; ++sd) {
        f32x16 c0 = {}, c1 = {}; const char* Sb = lds + (sd ? O_OFF_SB : O_OFF_RT) + (dvh * 64 + r32) * 256;
#pragma unroll
        for (int d0 = 0; d0 < 8; ++d0) { const int off = (d0 >> 2) * 128 + ((((d0 & 3) * 2 + hi) ^ sw) << 4);
            const bf16x8 b0 = *reinterpret_cast<const bf16x8*>(Sb + off), b1 = *reinterpret_cast<const bf16x8*>(Sb + off + 32 * 256);
            c0 = __builtin_amdgcn_mfma_f32_32x32x16_bf16(qr[d0], b0, c0, 0, 0, 0); c1 = __builtin_amdgcn_mfma_f32_32x32x16_bf16(qr[d0], b1, c1, 0, 0, 0); }
#pragma unroll
        for (int r = 0; r < 16; ++r) { const int j = qb * 32 + crow(r, hi); const float xi = sd ? __builtin_amdgcn_exp2f(l2b * (float)(128 - j)) : __builtin_amdgcn_exp2f(l2f * (float)(j + 1));
            o[0][r] += xi * c0[r]; o[1][r] += xi * c1[r]; }
    }
    float* stat = (float*)(lds + O_OFF_STAT);
    float s1[16], s2[16];
#pragma unroll
    for (int r = 0; r < 16; ++r) { float a = o[0][r] + o[1][r], q = o[0][r] * o[0][r] + o[1][r] * o[1][r];
#pragma unroll
        for (int m = 1; m < 32; m <<= 1) { a += __shfl_xor(a, m); q += __shfl_xor(q, m); }
        s1[r] = a; s2[r] = q; }
    if (r32 == 0) {
#pragma unroll
        for (int r = 0; r < 16; ++r) { stat[(wid * 32 + crow(r, hi)) * 2] = s1[r]; stat[(wid * 32 + crow(r, hi)) * 2 + 1] = s2[r]; } }
    __syncthreads();
    bf16_t* stg = (bf16_t*)(lds + O_OFF_K) + wid * 2048;
#pragma unroll
    for (int r = 0; r < 16; ++r) { const int rw = crow(r, hi); const float a = s1[r] + stat[((wid ^ 4) * 32 + rw) * 2], q = s2[r] + stat[((wid ^ 4) * 32 + rw) * 2 + 1];
        const float mean = a * (1.f / 128), var = fmaxf(q * (1.f / 128) - mean * mean, 0.f), rstd = 1.f / sqrtf(var + LN_EPS);
        stg[rw * 64 + r32] = (bf16_t)f2bf((o[0][r] - mean) * rstd); stg[rw * 64 + 32 + r32] = (bf16_t)f2bf((o[1][r] - mean) * rstd); }
    asm volatile("s_waitcnt lgkmcnt(0)" ::: "memory");
    { const bf16_t* gw = U + (row0 + qb * 32 + (lane >> 3)) * NU + U_RG + h * 128 + dvh * 64 + (lane & 7) * 8; bf16_t* yw = Y + (row0 + qb * 32 + (lane >> 3)) * DM + 1536 + h * 128 + dvh * 64 + (lane & 7) * 8;
      const bf16_t* sp = stg + (lane >> 3) * 64 + (lane & 7) * 8;
#pragma unroll
      for (int it = 0; it < 4; ++it) { const u32x4 ov = *(const u32x4*)(sp + it * 8 * 64), gv = *(const u32x4*)(gw + (long)it * 8 * NU); u32x4 w;
#pragma unroll
          for (int j = 0; j < 4; ++j) w[j] = pk2(__uint_as_float(ov[j] << 16) * __uint_as_float(gv[j] << 16), __uint_as_float(ov[j] & 0xffff0000u) * __uint_as_float(gv[j] & 0xffff0000u));
          *(u32x4*)(yw + (long)it * 8 * DM) = w; } }
    __syncthreads();
}
__device__ __forceinline__ void out_phase(const Params& p, int layer, int do_ctx, char* lds) {
    for (int unit = blockIdx.x; unit < NBATCH * 4 * 18; unit += gridDim.x) { const int bh = unit / 18, i = unit % 18; if (i < 2 && !do_ctx) continue; out_unit(p, layer, bh >> 2, bh & 3, i, lds); }
}
#undef PK4
#undef KSWZ
#undef SBAR
#undef PK
}
__global__ void __launch_bounds__(512, 2) ret_prep_kernel(Params p, int layer) {
    extern __shared__ __attribute__((aligned(16))) unsigned char lds[];
    ret::prep_phase(p, layer, (char*)lds);
}
__global__ void __launch_bounds__(512, 2) ret_out_kernel(Params p, int layer, int do_ctx) {
    extern __shared__ __attribute__((aligned(16))) unsigned char lds[];
    ret::out_phase(p, layer, do_ctx, (char*)lds);
}

namespace lru {
using mla::f32x16; using mla::crow;
constexpr int L_OFF_XLF = 0, L_OFF_XLB = 65536, L_OFF_XW = 98304, PREP_LDS = 98304 + 33280;
__device__ __forceinline__ float sigm(float v) { return 1.f / (1.f + __expf(-v)); }
template <int DIR> __device__ __forceinline__ void chunk_scan(const float (&a)[16], const float (&bb)[16], float (&hl)[16], float (&ac)[16], float& Ac, float& Bc, int hi) {
    float sa[4], sb[4];
#pragma unroll
    for (int q = 0; q < 4; ++q) { float h = 0.f, pa = 1.f;
#pragma unroll
        for (int e0 = 0; e0 < 4; ++e0) { const int e = DIR ? 3 - e0 : e0, r = q * 4 + e; h = a[r] * h + bb[r]; pa *= a[r]; hl[r] = h; ac[r] = pa; }
        sa[q] = pa; sb[q] = h; }
    float oa[4], ob[4];
#pragma unroll
    for (int q = 0; q < 4; ++q) { oa[q] = __shfl_xor(sa[q], 32); ob[q] = __shfl_xor(sb[q], 32); }
    float c = 0.f, P = 1.f, cin[4] = {0.f, 0.f, 0.f, 0.f}, pin[4] = {1.f, 1.f, 1.f, 1.f};
#pragma unroll
    for (int s0 = 0; s0 < 8; ++s0) { const int sg = DIR ? 7 - s0 : s0, q = sg >> 1; const bool mine = (sg & 1) == hi;
        const float A = mine ? sa[q] : oa[q], B = mine ? sb[q] : ob[q];
        if (mine) { cin[q] = c; pin[q] = P; }
        c = B + A * c; P *= A; }
#pragma unroll
    for (int r = 0; r < 16; ++r) { hl[r] += ac[r] * cin[r >> 2]; ac[r] *= pin[r >> 2]; }
    Ac = P; Bc = c;
}
__device__ __forceinline__ void prep_unit(const Params& p, int layer, int pm, int g, char* lds) {
    const int tid = threadIdx.x, wid = __builtin_amdgcn_readfirstlane(tid >> 6), lane = tid & 63, r32 = lane & 31, hi = lane >> 5;
    const bf16_t* U = (const bf16_t*)(p.ws + WS_U); const bf16_t* WG = (const bf16_t*)(p.ws + WS_LRUW) + (size_t)(layer * 8 + g) * 256 * 64;
    float* HL = (float*)(p.ws + WS_LRUB); float* AC = (float*)(p.ws + WS_LRUA); float* SUM = (float*)(p.ws + WS_LSUM);
    float* xlf = (float*)(lds + L_OFF_XLF); bf16_t* xin = (bf16_t*)(lds + L_OFF_XW);
    const long row0 = (long)pm * 256; const int s0 = (int)(row0 % SROW);
    const bool has_prev = !(s0 == 0 || s0 == CTXL), has_next = !(s0 == 0 || s0 == SROW - 256);
    for (int idx = tid; idx < 260 * 8; idx += 512) { const int ri = idx >> 3, c8 = (idx & 7) * 8;
        const bool valid = (ri >= 2 && ri < 258) || (ri < 2 && has_prev) || (ri >= 258 && has_next);
        u32x4 v = {0u, 0u, 0u, 0u}; if (valid) v = *(const u32x4*)(U + (row0 - 2 + ri) * NU + U_LRUX + g * 64 + c8);
        *(u32x4*)(xin + ri * 64 + c8) = v; }
    __syncthreads();
    { const int c2 = (tid & 31) * 2, tg = tid >> 5; const int ch = g * 64 + c2;
      float w0[4], w1[4];
#pragma unroll
      for (int k = 0; k < 4; ++k) { w0[k] = p.conv_w[(layer * 4 + k) * 512 + ch]; w1[k] = p.conv_w[(layer * 4 + k) * 512 + ch + 1]; }
      const float b0 = p.conv_b[layer * 512 + ch], b1 = p.conv_b[layer * 512 + ch + 1];
      for (int tt = 0; tt < 16; ++tt) { const int tok = tg * 16 + tt; float a0 = b0, a1 = b1;
#pragma unroll
          for (int k = 0; k < 4; ++k) { const unsigned xv = *(const unsigned*)(xin + (tok + k) * 64 + c2); a0 += __uint_as_float(xv << 16) * w0[k]; a1 += __uint_as_float(xv & 0xffff0000u) * w1[k]; }
          *(f32x2*)(xlf + tok * 64 + c2) = (f32x2){a0, a1};
          *(unsigned*)(lds + L_OFF_XLB + tok * 128 + (((c2 >> 3) ^ (tok & 7)) << 4) + (c2 & 7) * 2) = pk2(a0, a1); } }
    __syncthreads();
    { const int row = tid >> 1, half = tid & 1;
#pragma unroll
      for (int j = 0; j < 4; ++j) { const int chunk = half * 4 + j; *(u32x4*)(lds + L_OFF_XW + row * 128 + ((chunk ^ (row & 7)) << 4)) = *(const u32x4*)(WG + (size_t)row * 64 + chunk * 8); } }
    __syncthreads();
    bf16x8 af[4];
    { const int row = wid * 32 + r32;
#pragma unroll
      for (int ks = 0; ks < 4; ++ks) af[ks] = *reinterpret_cast<const bf16x8*>(lds + L_OFF_XLB + row * 128 + (((ks * 2 + hi) ^ (row & 7)) << 4)); }
    const long rowc = row0 + wid * 32; const int chunk_g = (int)(rowc >> 5);
#pragma unroll
    for (int d = 0; d < 2; ++d) {
        f32x16 acc[4] = {};
#pragma unroll
        for (int nbl = 0; nbl < 4; ++nbl) { const int orow = d * 128 + nbl * 32 + r32;
#pragma unroll
            for (int ks = 0; ks < 4; ++ks) { const bf16x8 bfr = *reinterpret_cast<const bf16x8*>(lds + L_OFF_XW + orow * 128 + (((ks * 2 + hi) ^ (orow & 7)) << 4));
                acc[nbl] = __builtin_amdgcn_mfma_f32_32x32x16_bf16(af[ks], bfr, acc[nbl], 0, 0, 0); } }
#pragma unroll
        for (int jh = 0; jh < 2; ++jh) {
            const int cl = jh * 32 + r32, ch = g * 64 + cl;
            const float br = p.b_r[(layer * 2 + d) * 512 + ch], bi = p.b_i[(layer * 2 + d) * 512 + ch];
            const float sp8 = 8.0f * log1pf(expf(-p.lam[(layer * 2 + d) * 512 + ch]));
            float a[16], bb[16], hl[16], ac[16], Ac, Bc;
#pragma unroll
            for (int r = 0; r < 16; ++r) { const int tok = wid * 32 + crow(r, hi);
                const float rg = sigm(acc[jh][r] + br), ig = sigm(acc[2 + jh][r] + bi); const float la = -sp8 * rg;
                a[r] = expf(la); bb[r] = sqrtf(-expm1f(2.0f * la)) * (ig * xlf[tok * 64 + cl]); }
            if (d == 0) chunk_scan<0>(a, bb, hl, ac, Ac, Bc, hi); else chunk_scan<1>(a, bb, hl, ac, Ac, Bc, hi);
            float* hp = HL + ((size_t)d * MROWS + rowc) * 512 + ch; float* ap = AC + ((size_t)d * MROWS + rowc) * 512 + ch;
#pragma unroll
            for (int r = 0; r < 16; ++r) { const int t = crow(r, hi); hp[(size_t)t * 512] = hl[r]; ap[(size_t)t * 512] = ac[r]; }
            if (hi == 0) { SUM[((size_t)(0 * 2 + d) * 288 + chunk_g) * 512 + ch] = Ac; SUM[((size_t)(1 * 2 + d) * 288 + chunk_g) * 512 + ch] = Bc; }
        }
    }
    __syncthreads();
}
__device__ __forceinline__ void prep_phase(const Params& p, int layer, char* lds) {
    for (int unit = blockIdx.x; unit < 36 * 8; unit += gridDim.x) prep_unit(p, layer, unit >> 3, unit & 7, lds);
}
__device__ __forceinline__ void out_unit(const Params& p, int pm, int g) {
    const int tid = threadIdx.x, wid = __builtin_amdgcn_readfirstlane(tid >> 6), lane = tid & 63;
    const bf16_t* U = (const bf16_t*)(p.ws + WS_U); bf16_t* Y = (bf16_t*)(p.ws + WS_Y);
    const float* HL = (const float*)(p.ws + WS_LRUB); const float* AC = (const float*)(p.ws + WS_LRUA); const float* SUM = (const float*)(p.ws + WS_LSUM);
    const long rowc = (long)pm * 256 + wid * 32; const int cg = (int)(rowc >> 5), b = cg / 72, c = cg % 72, ch = g * 64 + lane;
    const float* sAf = SUM + ((size_t)0 * 288 + b * 72) * 512 + ch; const float* sBf = SUM + ((size_t)2 * 288 + b * 72) * 512 + ch;
    const float* sAb = SUM + ((size_t)1 * 288 + b * 72) * 512 + ch; const float* sBb = SUM + ((size_t)3 * 288 + b * 72) * 512 + ch;
    float cf = 0.f, cb = 0.f;
    for (int k = 0; k < c; ++k) cf = sBf[(size_t)k * 512] + sAf[(size_t)k * 512] * cf;
    if (c < 8) { for (int k = 7; k > c; --k) cb = sBb[(size_t)k * 512] + sAb[(size_t)k * 512] * cb; }
    else { for (int k = 7; k >= 0; --k) cb = sBb[(size_t)k * 512] + sAb[(size_t)k * 512] * cb;
           for (int k = 71; k > c; --k) cb = sBb[(size_t)k * 512] + sAb[(size_t)k * 512] * cb; }
    const float* hf = HL + (size_t)rowc * 512 + ch; const float* af = AC + (size_t)rowc * 512 + ch;
    const float* hb = hf + (size_t)MROWS * 512; const float* ab = af + (size_t)MROWS * 512;
#pragma unroll 4
    for (int t = 0; t < 32; ++t) { const float v = (hf[(size_t)t * 512] + af[(size_t)t * 512] * cf) + (hb[(size_t)t * 512] + ab[(size_t)t * 512] * cb);
        const float gt = bf2f(U[(rowc + t) * NU + U_LRUG + ch]); Y[(rowc + t) * DM + 1024 + ch] = (bf16_t)f2bf(v * gt); }
}
__device__ __forceinline__ void out_phase(const Params& p, int do_ctx) {
    for (int unit = blockIdx.x; unit < 36 * 8; unit += gridDim.x) { const int pm = unit >> 3; if (!do_ctx && pm % 9 == 0) continue; out_unit(p, pm, unit & 7); }
}
}
__global__ void __launch_bounds__(512, 2) lru_prep_kernel(Params p, int layer) {
    extern __shared__ __attribute__((aligned(16))) unsigned char lds[];
    lru::prep_phase(p, layer, (char*)lds);
}
__global__ void __launch_bounds__(512, 2) lru_out_kernel2(Params p, int do_ctx) { lru::out_phase(p, do_ctx); }

template <class Epi>
__global__ void __launch_bounds__(512, 2) gemm_kernel(pg8::Gemm g, int nM, int nN, int skip, Epi E) {
    extern __shared__ __attribute__((aligned(16))) unsigned char lds[];
    pg8::StaticOrder S; S.init(nM, nN, gridDim.x, blockIdx.x, skip);
    pg8::gemm_phase<Epi>((LAS unsigned char*)lds, g, S, E);
}

__device__ __forceinline__ void transpose_item(const float* W, int K, int Nsrc, int Ndst, bf16_t* WT, int colmode, const float* kscale, LAS float* scr, int item, int lane) {
    const int nblk = Ndst / 32, kb = item / nblk, nb = item % nblk, k0 = 64 * kb, n0 = 32 * nb;
    const int n = n0 + (lane & 31); const int sc = colmode ? win_src_col(n) : n;
#pragma unroll 8
    for (int i = 0; i < 32; ++i) { const int kk = 2 * i + (lane >> 5); float v = sc >= 0 ? W[(size_t)(k0 + kk) * Nsrc + sc] : 0.f; if (kscale) v *= kscale[k0 + kk]; scr[kk * 33 + (lane & 31)] = v; }
    asm volatile("s_waitcnt lgkmcnt(0)" ::: "memory");
    const int c = lane & 7;
#pragma unroll
    for (int j = 0; j < 4; ++j) { const int nn = (lane >> 3) + 8 * j; const LAS float* s = scr + (8 * c) * 33 + nn;
        u32x4 o; o.x = pk2(s[0 * 33], s[1 * 33]); o.y = pk2(s[2 * 33], s[3 * 33]); o.z = pk2(s[4 * 33], s[5 * 33]); o.w = pk2(s[6 * 33], s[7 * 33]);
        *(u32x4*)(WT + (size_t)(n0 + nn) * K + k0 + 8 * c) = o; }
    asm volatile("s_waitcnt lgkmcnt(0)" ::: "memory");
}

__device__ __forceinline__ void sincos_d(float xf, float& s, float& c) {
    const double x = (double)xf; const double kq = rint(x * 0.63661977236758134308); const double r = x - kq * 1.57079632679489661923;
    const double r2 = r * r;
    const double sp = r * (1.0 + r2 * (-1.0 / 6 + r2 * (1.0 / 120 + r2 * (-1.0 / 5040 + r2 * (1.0 / 362880 + r2 * (-1.0 / 39916800 + r2 * (1.0 / 6227020800.0)))))));
    const double cp = 1.0 + r2 * (-0.5 + r2 * (1.0 / 24 + r2 * (-1.0 / 720 + r2 * (1.0 / 40320 + r2 * (-1.0 / 3628800 + r2 * (1.0 / 479001600.0))))));
    const int q = ((int)kq) & 3;
    const double ss = (q == 0) ? sp : (q == 1) ? cp : (q == 2) ? -sp : -cp;
    const double cc = (q == 0) ? cp : (q == 1) ? -sp : (q == 2) ? -cp : sp;
    s = (float)ss; c = (float)cc;
}

__global__ void __launch_bounds__(512) prep_kernel(Params p) {
    extern __shared__ __attribute__((aligned(16))) unsigned char lds[];
    const int tid = threadIdx.x, lane = tid & 63, wave = tid >> 6;
    LAS float* scr = (LAS float*)lds + wave * (64 * 33);
    const int gw = blockIdx.x * 8 + wave, NGW = gridDim.x * 8;
    { const int gt = blockIdx.x * 512 + tid; if (gt < 64 * 32) { const int pos = gt >> 5, fi = gt & 31;
        const float inv = exp2f(-(float)fi * (13.287712379549449f / 32.0f)); const float ang = (float)pos * inv; float s, c; sincos_d(ang, s, c);
        ((f32x2*)(p.ws + WS_ROPE))[gt] = (f32x2){c, s}; } }
    { bf16_t* WG = (bf16_t*)(p.ws + WS_LRUW);
      for (int e = blockIdx.x * 512 + tid; e < DEPTH * 8 * 256 * 64; e += gridDim.x * 512) { const int i = e & 63, o = (e >> 6) & 255, g = (e >> 14) & 7, l = e >> 17; const int d = o >> 7, gate = (o >> 6) & 1, j = o & 63;
          const float* w = gate ? p.w_i : p.w_r; WG[e] = (bf16_t)f2bf(w[((size_t)((l * 2 + d) * 8 + g) * 64 + i) * 64 + j]); } }
    constexpr int I_IN = (DM / 64) * (NU / 32), I_UQ = (512 / 64) * (NQ / 32), I_UKV = (256 / 64) * (NKV / 32), I_OUT = (DM / 64) * (DM / 32), I_L = I_IN + I_UQ + I_UKV + I_OUT;
    for (int it = gw; it < DEPTH * I_L; it += NGW) {
        const int l = it / I_L; int r = it % I_L;
        if (r < I_IN) { transpose_item(p.w_in + (size_t)l * DM * MIX_IN, DM, MIX_IN, NU, (bf16_t*)(p.ws + WS_WIN) + (size_t)l * NU * DM, 1, nullptr, scr, r, lane); continue; } r -= I_IN;
        if (r < I_UQ) { transpose_item(p.w_uq + (size_t)l * 512 * NQ, 512, NQ, NQ, (bf16_t*)(p.ws + WS_WUQ) + (size_t)l * NQ * 512, 0, p.q_norm_g + l * 512, scr, r, lane); continue; } r -= I_UQ;
        if (r < I_UKV) { transpose_item(p.w_ukv + (size_t)l * 256 * NKV, 256, NKV, NKV, (bf16_t*)(p.ws + WS_WUKV) + (size_t)l * NKV * 256, 0, p.kv_norm_g + l * 256, scr, r, lane); continue; } r -= I_UKV;
        transpose_item(p.w_out + (size_t)l * DM * DM, DM, DM, DM, (bf16_t*)(p.ws + WS_WOUT) + (size_t)l * DM * DM, 0, nullptr, scr, r, lane);
    }
}

__global__ void __launch_bounds__(512) ada_kernel(Params p) {
    extern __shared__ __attribute__((aligned(16))) unsigned char lds[];
    LAS float* sc = (LAS float*)lds;
    LAS float* red = sc + 5 * DM;
    const int tid = threadIdx.x, lane = tid & 63, wave = tid >> 6;
    for (int i = tid; i < 5 * DM; i += 512) { const float v = i < 4 * DM ? p.c[i] : p.c_ctx[i - 4 * DM]; sc[i] = silu_f(v); }
    __syncthreads();
    float* mod = (float*)(p.ws + WS_MOD);
    for (int unit = blockIdx.x; unit < DEPTH * 96; unit += gridDim.x) {
        const int l = unit / 96, col = (unit % 96) * 64 + lane;
        const float* w = p.w_ada + (size_t)l * DM * 6144 + col;
        float a0 = 0, a1 = 0, a2 = 0, a3 = 0, a4 = 0;
#pragma unroll 8
        for (int kk = 0; kk < 256; ++kk) { const int k = wave * 256 + kk; const float wv = w[(size_t)k * 6144];
            a0 += sc[k] * wv; a1 += sc[DM + k] * wv; a2 += sc[2 * DM + k] * wv; a3 += sc[3 * DM + k] * wv; a4 += sc[4 * DM + k] * wv; }
        red[(wave * 5 + 0) * 64 + lane] = a0; red[(wave * 5 + 1) * 64 + lane] = a1; red[(wave * 5 + 2) * 64 + lane] = a2; red[(wave * 5 + 3) * 64 + lane] = a3; red[(wave * 5 + 4) * 64 + lane] = a4;
        __syncthreads();
        if (wave < 5) { float s = 0; for (int w8 = 0; w8 < 8; ++w8) s += red[(w8 * 5 + wave) * 64 + lane];
            mod[((size_t)l * 5 + wave) * 6144 + col] = s + p.b_ada[l * 6144 + col]; }
        __syncthreads();
    }
}

__device__ __forceinline__ void ln_row(const float* src, const float* g, const float* b, float* dst, bf16_t* hm, const float* modc, int lane) {
    f32x4 v[8]; float s = 0.f;
#pragma unroll
    for (int j = 0; j < 8; ++j) { v[j] = *(const f32x4*)(src + j * 256 + lane * 4); s += (v[j][0] + v[j][1]) + (v[j][2] + v[j][3]); }
    const float mean = wave_sum(s) * (1.f / DM); float s2 = 0.f;
#pragma unroll
    for (int j = 0; j < 8; ++j) { v[j] = v[j] - mean; s2 += (v[j][0] * v[j][0] + v[j][1] * v[j][1]) + (v[j][2] * v[j][2] + v[j][3] * v[j][3]); }
    const float rstd = 1.f / sqrtf(wave_sum(s2) * (1.f / DM) + LN_EPS);
#pragma unroll
    for (int j = 0; j < 8; ++j) { const int c = j * 256 + lane * 4; f32x4 y = v[j] * rstd;
        if (g) { y = y * *(const f32x4*)(g + c) + *(const f32x4*)(b + c); }
        if (dst) *(f32x4*)(dst + c) = y;
        if (hm) { const f32x4 sh = *(const f32x4*)(modc + c), scl = *(const f32x4*)(modc + 2048 + c); const f32x4 z = y * (scl + 1.0f) + sh;
            u32x2 w; w.x = pk2(z[0], z[1]); w.y = pk2(z[2], z[3]); *(u32x2*)(hm + c) = w; } }
}
__global__ void __launch_bounds__(512) ln_kernel(Params p, int layer) {
    const int lane = threadIdx.x & 63, gw = blockIdx.x * 8 + (threadIdx.x >> 6), NGW = gridDim.x * 8;
    float* hres = (float*)(p.ws + WS_HRES); bf16_t* hmod = (bf16_t*)(p.ws + WS_HMOD); const float* mod = (const float*)(p.ws + WS_MOD);
    for (int row = gw; row < MROWS; row += NGW) {
        const int b = row / SROW, s = row % SROW, isctx = s < CTXL, cond = isctx ? 4 : b;
        if (layer < 0) { const float* src = isctx ? p.ctx + ((size_t)b * CTXL + s) * DM : p.x + ((size_t)b * SEQ + (s - CTXL)) * DM;
            ln_row(src, nullptr, nullptr, hres + (size_t)row * DM, hmod + (size_t)row * DM, mod + (size_t)(0 * 5 + cond) * 6144, lane); }
        else if (layer < DEPTH - 1) ln_row(hres + (size_t)row * DM, p.ln_g + layer * DM, p.ln_b + layer * DM, hres + (size_t)row * DM, hmod + (size_t)row * DM, mod + (size_t)((layer + 1) * 5 + cond) * 6144, lane);
        else if (!isctx) ln_row(hres + (size_t)row * DM, p.ln_g + layer * DM, p.ln_b + layer * DM, p.out + ((size_t)b * SEQ + (s - CTXL)) * DM, nullptr, nullptr, lane);
    }
}

__global__ void __launch_bounds__(256) u_fix_kernel(Params p) {
    bf16_t* U = (bf16_t*)(p.ws + WS_U); const f32x2* cs = (const f32x2*)(p.ws + WS_ROPE);
    const long total = (long)MROWS * (NU / 8);
    for (long i = blockIdx.x * 256L + threadIdx.x; i < total; i += gridDim.x * 256L) {
        const int row = (int)(i / (NU / 8)), un = (int)(i % (NU / 8)); const int c0 = (un >> 2) * 32 + (un & 3) * 4;
        if (c0 < U_GMLA) continue;
        bf16_t* q = U + (size_t)row * NU + c0; f32x4 v0 = ld4bf(q), v1 = ld4bf(q + 16);
        in_transform(row, c0, v0, v1, cs); st4bf(q, v0); st4bf(q + 16, v1);
    }
}
__global__ void __launch_bounds__(256) rstd_kernel(Params p) {
    const bf16_t* U = (const bf16_t*)(p.ws + WS_U); float* rs = (float*)(p.ws + WS_RSTD);
    const int lane = threadIdx.x & 63, gw = blockIdx.x * 4 + (threadIdx.x >> 6), NGW = gridDim.x * 4;
    for (int row = gw; row < MROWS; row += NGW) {
        const bf16_t* u = U + (size_t)row * NU; float sq = 0.f, sk = 0.f;
        for (int j = lane; j < 512; j += 64) { const float v = bf2f(u[j]); sq += v * v; }
        for (int j = lane; j < 256; j += 64) { const float v = bf2f(u[512 + j]); sk += v * v; }
        sq = wave_sum(sq); sk = wave_sum(sk);
        if (lane == 0) { rs[row * 2] = 1.f / sqrtf(sq * (1.f / 512) + RMS_EPS); rs[row * 2 + 1] = 1.f / sqrtf(sk * (1.f / 256) + RMS_EPS); }
    }
}
__global__ void __launch_bounds__(256) q_fix_kernel(Params p) {
    bf16_t* Q = (bf16_t*)(p.ws + WS_Q); const f32x2* cs = (const f32x2*)(p.ws + WS_ROPE);
    const long total = (long)MROWS * 8 * 32;
    for (long i = blockIdx.x * 256L + threadIdx.x; i < total; i += gridDim.x * 256L) {
        const int row = (int)(i >> 8), r = (int)(i & 255), h = r >> 5, a = (r >> 4) & 1, ii = r & 15;
        const int s = row % SROW; if (s < CTXL) continue; const int t = s - CTXL, pos = a ? (t & 63) : (t >> 6);
        bf16_t* q = Q + (size_t)row * NQ + h * 192 + 128 + a * 32 + ii; const f32x2 c = cs[pos * 32 + 2 * ii];
        const float x1 = bf2f(q[0]), x2 = bf2f(q[16]); q[0] = (bf16_t)f2bf(x1 * c[0] - x2 * c[1]); q[16] = (bf16_t)f2bf(x2 * c[0] + x1 * c[1]);
    }
}

template <int MODE>
__global__ void __launch_bounds__(64) naive_mix_kernel(Params p, int layer, int do_ctx) {
    extern __shared__ __attribute__((aligned(16))) unsigned char lds[];
    constexpr int DQK = MODE == 0 ? 192 : 128, NH = MODE == 0 ? 8 : 4;
    LAS float* S = (LAS float*)lds;
    LAS float* qs = S + 4 * SROW;
    const int lane = threadIdx.x;
    const bf16_t* U = (const bf16_t*)(p.ws + WS_U); const bf16_t* Q = (const bf16_t*)(p.ws + WS_Q); const bf16_t* KV = (const bf16_t*)(p.ws + WS_KV); bf16_t* Y = (bf16_t*)(p.ws + WS_Y);
    const int ngroups = NBATCH * NH * (SROW / 4);
    for (int grp = blockIdx.x; grp < ngroups; grp += gridDim.x) {
        const int b = grp / (NH * (SROW / 4)), rem = grp % (NH * (SROW / 4)), h = rem / (SROW / 4), s0 = (rem % (SROW / 4)) * 4;
        const bool isctx = s0 < CTXL; if (isctx && !do_ctx) continue;
        const int nkeys = isctx ? CTXL : SROW; const int rowbase = b * SROW;
        float lgf = 0.f, lgb = 0.f;
        if (MODE == 1) { const float df = p.ret_decay[(layer * 2 + 0) * 4 + h], db = p.ret_decay[(layer * 2 + 1) * 4 + h]; lgf = -log1pf(expf(-df)); lgb = -log1pf(expf(-db)); }
        __syncthreads();
        for (int i = lane; i < 4 * DQK; i += 64) { const int qi = i / DQK, d = i % DQK; const int row = rowbase + s0 + qi;
            qs[i] = MODE == 0 ? bf2f(Q[(size_t)row * NQ + h * 192 + d]) : bf2f(U[(size_t)row * NU + U_RQ + h * 128 + d]); }
        __syncthreads();
        float mx[4] = {-1e30f, -1e30f, -1e30f, -1e30f};
        for (int k = lane; k < nkeys; k += 64) {
            const int krow = rowbase + k; float d0 = 0, d1 = 0, d2 = 0, d3 = 0;
            if (MODE == 0) {
                const bf16_t* kn = KV + (size_t)krow * NKV + h * 256; const bf16_t* kr = U + (size_t)krow * NU + U_KR;
                for (int d = 0; d < 128; ++d) { const float kv = bf2f(kn[d]); d0 += qs[d] * kv; d1 += qs[192 + d] * kv; d2 += qs[384 + d] * kv; d3 += qs[576 + d] * kv; }
                for (int d = 0; d < 64; ++d) { const float kv = bf2f(kr[d]); d0 += qs[128 + d] * kv; d1 += qs[192 + 128 + d] * kv; d2 += qs[384 + 128 + d] * kv; d3 += qs[576 + 128 + d] * kv; }
                d0 *= MLA_SCALE; d1 *= MLA_SCALE; d2 *= MLA_SCALE; d3 *= MLA_SCALE;
            } else {
                const bf16_t* kk = U + (size_t)krow * NU + U_RK + h * 128;
                for (int d = 0; d < 128; ++d) { const float kv = bf2f(kk[d]); d0 += qs[d] * kv; d1 += qs[128 + d] * kv; d2 += qs[256 + d] * kv; d3 += qs[384 + d] * kv; }
                float dd[4] = {d0, d1, d2, d3};
                for (int qi = 0; qi < 4; ++qi) { const int sq = s0 + qi; float w;
                    if (isctx) { const int n = sq, m = k; w = m <= n ? expf((float)(n - m) * lgf) : expf((float)(m - n) * lgb); }
                    else { const int n = sq - CTXL;
                        if (k < CTXL) w = expf((float)(n + CTXL - k) * lgf) + expf((float)(SEQ - n + k) * lgb);
                        else { const int m = k - CTXL; w = m <= n ? expf((float)(n - m) * lgf) : expf((float)(m - n) * lgb); } }
                    dd[qi] *= w; }
                d0 = dd[0]; d1 = dd[1]; d2 = dd[2]; d3 = dd[3];
            }
            S[k] = d0; S[SROW + k] = d1; S[2 * SROW + k] = d2; S[3 * SROW + k] = d3;
            mx[0] = fmaxf(mx[0], d0); mx[1] = fmaxf(mx[1], d1); mx[2] = fmaxf(mx[2], d2); mx[3] = fmaxf(mx[3], d3);
        }
        float inv[4] = {1.f, 1.f, 1.f, 1.f};
        if (MODE == 0) {
            for (int qi = 0; qi < 4; ++qi) { const float m = wave_max(mx[qi]); float sum = 0.f;
                for (int k = lane; k < nkeys; k += 64) { const float e = expf(S[qi * SROW + k] - m); S[qi * SROW + k] = e; sum += e; }
                inv[qi] = 1.f / wave_sum(sum); }
        }
        __syncthreads();
        float o[4][2] = {{0, 0}, {0, 0}, {0, 0}, {0, 0}};
        for (int k = 0; k < nkeys; ++k) {
            const int krow = rowbase + k;
            const unsigned vv = MODE == 0 ? *(const unsigned*)(KV + (size_t)krow * NKV + h * 256 + 128 + 2 * lane) : *(const unsigned*)(U + (size_t)krow * NU + U_RV + h * 128 + 2 * lane);
            const float v0 = __uint_as_float(vv << 16), v1 = __uint_as_float(vv & 0xffff0000u);
#pragma unroll
            for (int qi = 0; qi < 4; ++qi) { const float pw = S[qi * SROW + k]; o[qi][0] += pw * v0; o[qi][1] += pw * v1; }
        }
        for (int qi = 0; qi < 4; ++qi) {
            const int row = rowbase + s0 + qi; float y0 = o[qi][0] * inv[qi], y1 = o[qi][1] * inv[qi];
            if (MODE == 1) { const float mean = wave_sum(y0 + y1) * (1.f / 128); y0 -= mean; y1 -= mean; const float var = wave_sum(y0 * y0 + y1 * y1) * (1.f / 128); const float rstd = 1.f / sqrtf(var + LN_EPS); y0 *= rstd; y1 *= rstd; }
            const unsigned gg = *(const unsigned*)(U + (size_t)row * NU + (MODE == 0 ? U_GMLA : U_RG) + h * 128 + 2 * lane);
            y0 *= __uint_as_float(gg << 16); y1 *= __uint_as_float(gg & 0xffff0000u);
            *(unsigned*)(Y + (size_t)row * DM + (MODE == 0 ? 0 : 1536) + h * 128 + 2 * lane) = pk2(y0, y1);
        }
    }
}

__global__ void __launch_bounds__(512) lru_ab_kernel(Params p, int layer) {
    __shared__ float xl[512];
    const bf16_t* U = (const bf16_t*)(p.ws + WS_U); float* A = (float*)(p.ws + WS_LRUA); float* Bc = (float*)(p.ws + WS_LRUB);
    const int ch = threadIdx.x, g = ch >> 6, j = ch & 63;
    for (int row = blockIdx.x; row < MROWS; row += gridDim.x) {
        const int s = row % SROW; const int lo = s < CTXL ? 0 : CTXL, hi = s < CTXL ? CTXL : SROW;
        float acc = p.conv_b[layer * 512 + ch];
#pragma unroll
        for (int k = 0; k < 4; ++k) { const int ss = s + k - 2; if (ss >= lo && ss < hi) acc += bf2f(U[(size_t)(row + k - 2) * NU + U_LRUX + ch]) * p.conv_w[(layer * 4 + k) * 512 + ch]; }
        __syncthreads();
        xl[ch] = acc;
        __syncthreads();
#pragma unroll 1
        for (int d = 0; d < 2; ++d) {
            const float* wr = p.w_r + ((size_t)((layer * 2 + d) * 8 + g) * 64) * 64 + j; const float* wi = p.w_i + ((size_t)((layer * 2 + d) * 8 + g) * 64) * 64 + j;
            float r = p.b_r[(layer * 2 + d) * 512 + ch], ig = p.b_i[(layer * 2 + d) * 512 + ch];
#pragma unroll 4
            for (int i = 0; i < 64; ++i) { const float xv = xl[g * 64 + i]; r += xv * wr[i * 64]; ig += xv * wi[i * 64]; }
            r = 1.f / (1.f + expf(-r)); ig = 1.f / (1.f + expf(-ig));
            const float lm = p.lam[(layer * 2 + d) * 512 + ch]; const float sp = log1pf(expf(-lm));
            const float log_a = -8.0f * r * sp; const float a = expf(log_a); const float mult = sqrtf(-expm1f(2.0f * log_a));
            A[((size_t)d * MROWS + row) * 512 + ch] = a; Bc[((size_t)d * MROWS + row) * 512 + ch] = mult * (ig * acc);
        }
    }
}
__global__ void __launch_bounds__(64) lru_scan_kernel(Params p) {
    const float* A = (const float*)(p.ws + WS_LRUA); float* Bc = (float*)(p.ws + WS_LRUB);
    const int id = blockIdx.x * 64 + threadIdx.x; if (id >= NBATCH * 2 * 512) return;
    const int ch = id & 511, d = (id >> 9) & 1, b = id >> 10;
    const size_t base = ((size_t)d * MROWS + (size_t)b * SROW) * 512 + ch;
    float h = 0.f;
    if (d == 0) { for (int s = 0; s < SROW; ++s) { const size_t o = base + (size_t)s * 512; h = A[o] * h + Bc[o]; Bc[o] = h; } }
    else { for (int s = CTXL - 1; s >= 0; --s) { const size_t o = base + (size_t)s * 512; h = A[o] * h + Bc[o]; Bc[o] = h; }
           for (int s = SROW - 1; s >= CTXL; --s) { const size_t o = base + (size_t)s * 512; h = A[o] * h + Bc[o]; Bc[o] = h; } }
}
__global__ void __launch_bounds__(256) lru_out_kernel(Params p) {
    const float* H = (const float*)(p.ws + WS_LRUB); const bf16_t* U = (const bf16_t*)(p.ws + WS_U); bf16_t* Y = (bf16_t*)(p.ws + WS_Y);
    const long total = (long)MROWS * 512;
    for (long i = blockIdx.x * 256L + threadIdx.x; i < total; i += gridDim.x * 256L) {
        const int row = (int)(i >> 9), ch = (int)(i & 511);
        const float v = (H[i] + H[(size_t)MROWS * 512 + i]) * bf2f(U[(size_t)row * NU + U_LRUG + ch]);
        Y[(size_t)row * DM + 1024 + ch] = (bf16_t)f2bf(v);
    }
}


#define XB_TMO      128
#define XB_XCNT(j)  (256  + 64 * (j))
#define XB_XSUB(j)  (1280 + 64 * (j))
#define XB_XGEN(j)  (2304 + 64 * (j))
#define XB_TOP      3328
#define XB_TOPGEN   3392
#define XCD_BAR_WORDS 3456
#define XB_SPIN_CAP (1u << 18)
__device__ __forceinline__ unsigned xb_ld(unsigned* p)              { return __hip_atomic_load(p, __ATOMIC_RELAXED, __HIP_MEMORY_SCOPE_AGENT); }
__device__ __forceinline__ unsigned xb_add(unsigned* p, unsigned v) { return __hip_atomic_fetch_add(p, v, __ATOMIC_RELAXED, __HIP_MEMORY_SCOPE_AGENT); }
__device__ __forceinline__ unsigned xb_xcc_id() { return (unsigned)__builtin_amdgcn_s_getreg((3 << 11) | 20) & 0xFu; }
#define XB_SPIN(cond, bar) do { unsigned _sp = 0; while (cond) { __builtin_amdgcn_s_sleep(1); \
    if ((++_sp & 255u) == 0u) { if (xb_ld(&(bar)[XB_TMO])) break; if (_sp > XB_SPIN_CAP) { atomicAdd(&(bar)[XB_TMO], 1u); break; } } } } while (0)
struct XcdBarrier { unsigned* bar; unsigned x; volatile LAS unsigned* st; };
__device__ __forceinline__ XcdBarrier xcd_barrier_post(unsigned* bar, volatile LAS unsigned* st) {
    XcdBarrier b; b.bar = bar; b.x = xb_xcc_id(); b.st = st;
    if (threadIdx.x == 0) (void)xb_add(&bar[XB_XCNT(b.x)], 1u);
    return b;
}
__device__ __forceinline__ void xcd_barrier_complete(unsigned* bar, unsigned x, unsigned& nloc, unsigned& nx) {
    const unsigned G = gridDim.x * gridDim.y * gridDim.z;
    unsigned sum, cnt, mine, sp = 0u;
    for (;;) {
        sum = 0u; cnt = 0u; mine = 0u;
#pragma unroll
        for (unsigned j = 0; j < 16; ++j) { const unsigned c = xb_ld(&bar[XB_XCNT(j)]); sum += c; cnt += (c > 0u) ? 1u : 0u; mine = (j == x) ? c : mine; }
        if (sum == G) break;
        __builtin_amdgcn_s_sleep(1);
        if ((++sp & 255u) == 0u) { if (xb_ld(&bar[XB_TMO])) break; if (sp > XB_SPIN_CAP) { atomicAdd(&bar[XB_TMO], 1u); break; } }
    }
    nloc = mine > 0u ? mine : 1u; nx = cnt > 0u ? cnt : 1u;
}
__device__ __forceinline__ void xcd_barrier(const XcdBarrier& b) {
    asm volatile("s_waitcnt vmcnt(0)" ::: "memory");
    __syncthreads();
    if (threadIdx.x == 0) {
        unsigned* bar = b.bar;
        __builtin_amdgcn_s_waitcnt(0);
        unsigned nloc = b.st[0], nx = b.st[1];
        if (nloc == 0u) { xcd_barrier_complete(bar, b.x, nloc, nx); b.st[0] = nloc; b.st[1] = nx; }
        const unsigned old = xb_add(&bar[XB_XSUB(b.x)], 1u);
        const unsigned gen = old / nloc;
        if (old + 1u == (gen + 1u) * nloc) {
            __builtin_amdgcn_fence(__ATOMIC_RELEASE, "agent");
            asm volatile("s_waitcnt vmcnt(0)" ::: "memory");
            const unsigned og = xb_add(&bar[XB_TOP], 1u);
            const unsigned tg = og / nx;
            if (og + 1u == (tg + 1u) * nx) xb_add(&bar[XB_TOPGEN], 1u);
            else XB_SPIN(xb_ld(&bar[XB_TOPGEN]) == tg, bar);
            __builtin_amdgcn_fence(__ATOMIC_ACQUIRE, "agent");
            xb_add(&bar[XB_XGEN(b.x)], 1u);
            asm volatile("s_waitcnt vmcnt(0)" ::: "memory");
        } else {
            XB_SPIN(xb_ld(&bar[XB_XGEN(b.x)]) == gen, bar);
            __builtin_amdgcn_fence(__ATOMIC_ACQUIRE, "agent");
            asm volatile("s_waitcnt vmcnt(0)" ::: "memory");
        }
    }
    __syncthreads();
}

constexpr int SK_LDS = 147456, SK_NR = 100;
__global__ void __launch_bounds__(512, 2) skel_kernel(Params p) {
    extern __shared__ __attribute__((aligned(16))) unsigned char lds[];
    namespace cg = cooperative_groups;
    cg::grid_group grid = cg::this_grid();
    volatile LAS unsigned* MISC = (volatile LAS unsigned*)((LAS unsigned char*)lds + 131072);
    if (threadIdx.x < 64) MISC[threadIdx.x] = 0u;
    __syncthreads();
    unsigned* ctl = (unsigned*)(p.ws + WS_CTL);
    XcdBarrier bar = xcd_barrier_post(ctl + 4096, MISC + 8);
    unsigned* slots = ctl + 65536;
    const unsigned G = gridDim.x; bool bad = false;
    for (int r = 0; r < SK_NR; ++r) {
        if (threadIdx.x == 0) slots[(r & 1) * 1024 + blockIdx.x] = (unsigned)r * 1000u + blockIdx.x;
        if (r == 0) grid.sync(); else xcd_barrier(bar);
        const unsigned o = (blockIdx.x + threadIdx.x) % G; const unsigned v = slots[(r & 1) * 1024 + o];
        if (v != (unsigned)r * 1000u + o) bad = true;
    }
    if (bad) p.out[blockIdx.x * 512 + threadIdx.x] = __builtin_nanf("");
    if (threadIdx.x == 0 && xb_ld(&bar.bar[XB_TMO]) != 0u) p.out[DM + blockIdx.x] = __builtin_nanf("");
}

extern "C" void kernel_launch(void* const* d_in, const int* in_sizes, int n_in, void* d_out, int out_size, void* d_ws, size_t ws_size, hipStream_t stream) {
    static int ok = 0;
    if (ok == 0) {
        if (n_in != 22 || in_sizes[0] != NBATCH * SEQ * DM || out_size != NBATCH * SEQ * DM || ws_size < WS_END) {
            fprintf(stderr, "kernel_launch: unexpected shapes: n_in %d in0 %d out %d ws %zu (need %zu)\n", n_in, n_in > 0 ? in_sizes[0] : -1, out_size, ws_size, (size_t)WS_END); ok = -1; return; }
        hipFuncSetAttribute((const void*)gemm_kernel<pg8::EpiIn>, hipFuncAttributeMaxDynamicSharedMemorySize, 131072);
        hipFuncSetAttribute((const void*)gemm_kernel<pg8::EpiUp<0>>, hipFuncAttributeMaxDynamicSharedMemorySize, 131072);
        hipFuncSetAttribute((const void*)gemm_kernel<pg8::EpiUp<1>>, hipFuncAttributeMaxDynamicSharedMemorySize, 131072);
        hipFuncSetAttribute((const void*)attn_kernel, hipFuncAttributeMaxDynamicSharedMemorySize, mla::LDS_BYTES);
        hipFuncSetAttribute((const void*)lru_prep_kernel, hipFuncAttributeMaxDynamicSharedMemorySize, lru::PREP_LDS);
        hipFuncSetAttribute((const void*)ret_prep_kernel, hipFuncAttributeMaxDynamicSharedMemorySize, ret::PREP_LDS);
        hipFuncSetAttribute((const void*)ret_out_kernel, hipFuncAttributeMaxDynamicSharedMemorySize, ret::OUT_LDS);
        hipFuncSetAttribute((const void*)gemm_kernel<pg8::EpiResid>, hipFuncAttributeMaxDynamicSharedMemorySize, 131072);
        hipFuncSetAttribute((const void*)prep_kernel, hipFuncAttributeMaxDynamicSharedMemorySize, 8 * 64 * 33 * 4);
        hipFuncSetAttribute((const void*)ada_kernel, hipFuncAttributeMaxDynamicSharedMemorySize, (5 * DM + 8 * 5 * 64) * 4);
        hipFuncSetAttribute((const void*)naive_mix_kernel<0>, hipFuncAttributeMaxDynamicSharedMemorySize, (4 * SROW + 4 * 192) * 4);
        hipFuncSetAttribute((const void*)naive_mix_kernel<1>, hipFuncAttributeMaxDynamicSharedMemorySize, (4 * SROW + 4 * 192) * 4);
        hipFuncSetAttribute((const void*)skel_kernel, hipFuncAttributeMaxDynamicSharedMemorySize, SK_LDS);
        { int per_cu = 0; hipOccupancyMaxActiveBlocksPerMultiprocessor(&per_cu, (const void*)skel_kernel, 512, SK_LDS); fprintf(stderr, "skel occupancy per CU: %d\n", per_cu); }
        ok = 1;
    }
    if (ok < 0) return;
    Params p{};
    const float** f = (const float**)&p;
    for (int i = 0; i < 22; ++i) f[i] = (const float*)d_in[i];
    p.out = (float*)d_out; p.ws = (unsigned char*)d_ws;
    unsigned char* ws = p.ws;
    hipMemsetAsync(ws + WS_CTL, 0, 1 * MiB, stream);
    prep_kernel<<<256, 512, 8 * 64 * 33 * 4, stream>>>(p);
    ada_kernel<<<256, 512, (5 * DM + 8 * 5 * 64) * 4, stream>>>(p);
    ln_kernel<<<256, 512, 0, stream>>>(p, -1);
    for (int l = 0; l < DEPTH; ++l) {
        const int last = (l == DEPTH - 1);
        { pg8::Gemm g{(const bf16_t*)(ws + WS_HMOD), (const bf16_t*)(ws + WS_WIN) + (size_t)l * NU * DM, DM, DM, DM, 0};
          pg8::EpiIn E{(bf16_t*)(ws + WS_U), (float*)(ws + WS_SSQ), (const f32x2*)(ws + WS_ROPE)};
          gemm_kernel<pg8::EpiIn><<<256, 512, 131072, stream>>>(g, 36, NU / 256, 0, E); }
        { pg8::Gemm g{(const bf16_t*)(ws + WS_U) + U_QLAT, (const bf16_t*)(ws + WS_WUQ) + (size_t)l * NQ * 512, NU, 512, 512, 0};
          pg8::EpiUp<0> E{(bf16_t*)(ws + WS_Q), (const float*)(ws + WS_SSQ), (const f32x2*)(ws + WS_ROPE)};
          gemm_kernel<pg8::EpiUp<0>><<<256, 512, 131072, stream>>>(g, last ? 32 : 36, NQ / 256, last, E); }
        { pg8::Gemm g{(const bf16_t*)(ws + WS_U) + U_KVLAT, (const bf16_t*)(ws + WS_WUKV) + (size_t)l * NKV * 256, NU, 256, 256, 0};
          pg8::EpiUp<1> E{(bf16_t*)(ws + WS_KV), (const float*)(ws + WS_SSQ), (const f32x2*)(ws + WS_ROPE)};
          gemm_kernel<pg8::EpiUp<1>><<<256, 512, 131072, stream>>>(g, 36, NKV / 256, 0, E); }
        attn_kernel<<<256, 512, mla::LDS_BYTES, stream>>>(p, !last);
        ret_prep_kernel<<<256, 512, ret::PREP_LDS, stream>>>(p, l);
        ret_out_kernel<<<256, 512, ret::OUT_LDS, stream>>>(p, l, !last);
        lru_prep_kernel<<<256, 512, lru::PREP_LDS, stream>>>(p, l);
        lru_out_kernel2<<<256, 512, 0, stream>>>(p, !last);
        { pg8::Gemm g{(const bf16_t*)(ws + WS_Y), (const bf16_t*)(ws + WS_WOUT) + (size_t)l * DM * DM, DM, DM, DM, 0};
          pg8::EpiResid E{(float*)(ws + WS_HRES), (const float*)(ws + WS_MOD) + (size_t)l * 5 * 6144};
          gemm_kernel<pg8::EpiResid><<<256, 512, 131072, stream>>>(g, last ? 32 : 36, DM / 256, last, E); }
        ln_kernel<<<256, 512, 0, stream>>>(p, l);
    }
}
```
